# Optimizing an MI355X kernel written in HIP

```python
import math
import jax, jax.numpy as jnp
from jax import lax
import numpy as np

D_MODEL = 1024
BATCH = 8
SEQ = 2048
DEPTH = 2
DEC_BATCH = 128
DEC_SEQ = 8
PAST_LEN = 16384
PAGE_SIZE = 128

CONV_W = 4
N_BRANCH = 3
EPS = 1e-6
RG_WIDTH = D_MODEL // 2
RG_BLOCKS = 8
RG_BLOCK = RG_WIDTH // RG_BLOCKS
RG_C = 8.0
S5_WIDTH = D_MODEL // 2
S5_GROUP = 16
S5_GROUPS = S5_WIDTH // S5_GROUP
S5_STATE = 64
GDN_HEADS = 4
GDN_DK = 128
GDN_DV = 128
GDN_QK = GDN_HEADS * GDN_DK
GDN_V = GDN_HEADS * GDN_DV
QKV_WIDTH = 2 * GDN_QK + GDN_V
GDN_CHUNK = 64
D_FF = ((8 * D_MODEL + 3 * 256 - 1) // (3 * 256)) * 256
N_IN = 2 * RG_WIDTH + S5_WIDTH + QKV_WIDTH + GDN_V + 2 * GDN_HEADS + N_BRANCH * D_MODEL

kernel_name = "hybrid_rglru_s5_gdn_decode_step"


def split_points():
    sizes = (RG_WIDTH, RG_WIDTH, S5_WIDTH, QKV_WIDTH, GDN_V, GDN_HEADS, GDN_HEADS, N_BRANCH * D_MODEL)
    return [int(v) for v in np.cumsum(sizes)[:-1]]


def rmsnorm(x, g):
    xf = x.astype(jnp.float32)
    y = xf * lax.rsqrt(jnp.mean(xf * xf, axis=-1, keepdims=True) + EPS) * g.astype(jnp.float32)
    return y.astype(x.dtype)


def l2norm(x):
    return x * lax.rsqrt(jnp.sum(x * x, axis=-1, keepdims=True) + EPS)


def causal_conv(x, buf, w):
    T = x.shape[1]
    xp = jnp.concatenate([buf.astype(x.dtype), x], axis=1)
    y = xp[:, 0:T] * w[0]
    for k in range(1, CONV_W):
        y = y + xp[:, k:k + T] * w[k]
    return y, xp[:, -(CONV_W - 1):]


def linear_scan(a, b, h0):
    b = b.at[:, 0].add(a[:, 0] * h0)
    def combine(l, r):
        return l[0] * r[0], r[0] * l[1] + r[1]
    _, h = lax.associative_scan(combine, (a, b), axis=1)
    return h


def rglru_branch(xr, gate_in, conv_buf, h0, conv_w, conv_b, wa, ba, wx, bx, lam, w_o):
    B, T, _ = xr.shape
    xc, new_buf = causal_conv(xr, conv_buf, conv_w)
    xc = xc + conv_b
    xb = xc.reshape(B, T, RG_BLOCKS, RG_BLOCK)
    r = jax.nn.sigmoid(jnp.einsum("btni,nij->btnj", xb, wa).reshape(B, T, RG_WIDTH) + ba).astype(jnp.float32)
    i = jax.nn.sigmoid(jnp.einsum("btni,nij->btnj", xb, wx).reshape(B, T, RG_WIDTH) + bx).astype(jnp.float32)
    log_a = -RG_C * r * jax.nn.softplus(-lam.astype(jnp.float32))
    a = jnp.exp(log_a)
    inp = jnp.sqrt(-jnp.expm1(2.0 * log_a)) * (i * xc.astype(jnp.float32))
    h = linear_scan(a, inp, h0.astype(jnp.float32))
    y = h.astype(xr.dtype) * jax.nn.gelu(gate_in)
    return y @ w_o, new_buf, h[:, -1]


def s5_branch(u, s_re, s_im, a_re, a_im, b_re, b_im, c_re, c_im, d, log_dt, glu_w, glu_b, w_o):
    B, T, _ = u.shape
    f32 = jnp.float32
    lam = lax.complex(a_re.astype(f32), a_im.astype(f32))
    dt = jnp.exp(log_dt.astype(f32))[:, None]
    lam_bar = jnp.exp(lam * dt)
    b_bar = ((lam_bar - 1.0) / lam)[..., None] * lax.complex(b_re.astype(f32), b_im.astype(f32))
    c_c = lax.complex(c_re.astype(f32), c_im.astype(f32))
    ug = u.astype(f32).reshape(B, T, S5_GROUPS, S5_GROUP)
    bu = jnp.einsum("gph,btgh->btgp", b_bar, ug)
    a = jnp.broadcast_to(lam_bar, bu.shape)
    s = linear_scan(a, bu, lax.complex(s_re.astype(f32), s_im.astype(f32)))
    y = jnp.einsum("ghp,btgp->btgh", c_c, s).real + d.astype(f32).reshape(S5_GROUPS, S5_GROUP) * ug
    y = jax.nn.gelu(y.reshape(B, T, S5_WIDTH)).astype(u.dtype)
    y = y * jax.nn.sigmoid(y @ glu_w + glu_b)
    s_last = s[:, -1]
    return y @ w_o, s_last.real, s_last.imag


def chunk_gated_delta(q, k, v, beta, g, S0):
    B, T, H, _ = q.shape
    C = min(GDN_CHUNK, T)
    pad = (-T) % C
    if pad:
        def padt(t):
            return jnp.pad(t, [(0, 0), (0, pad)] + [(0, 0)] * (t.ndim - 2))
        q, k, v, beta, g = padt(q), padt(k), padt(v), padt(beta), padt(g)
    N = (T + pad) // C
    def chunks(t):
        t = t.reshape((B, N, C, H) + t.shape[3:])
        return jnp.swapaxes(jnp.moveaxis(t, 1, 0), 2, 3)
    q, k, v, beta, g = chunks(q), chunks(k), chunks(v), chunks(beta), chunks(g)
    gc = jnp.cumsum(g, axis=-1)
    kb = k * beta[..., None]
    vb = v * beta[..., None]
    causal = jnp.tril(jnp.ones((C, C), bool))
    strict = jnp.tril(jnp.ones((C, C), bool), -1)
    diff = gc[..., :, None] - gc[..., None, :]
    decay = jnp.where(causal, jnp.exp(jnp.where(causal, diff, 0.0)), 0.0)
    lmat = jnp.where(strict, jnp.einsum("nbhid,nbhjd->nbhij", kb, k) * decay, 0.0)
    eye = jnp.eye(C, dtype=jnp.float32)
    tmat = lax.linalg.triangular_solve(eye + lmat, jnp.broadcast_to(eye, lmat.shape), left_side=True, lower=True)
    u = tmat @ vb
    w = tmat @ (kb * jnp.exp(gc)[..., None])
    qk = jnp.where(causal, jnp.einsum("nbhid,nbhjd->nbhij", q, k) * decay, 0.0)

    def step(S, xs):
        q_i, k_i, u_i, w_i, qk_i, g_i = xs
        v_new = u_i - w_i @ S
        o_i = (q_i * jnp.exp(g_i)[..., None]) @ S + qk_i @ v_new
        g_last = g_i[..., -1]
        k_dec = k_i * jnp.exp(g_last[..., None] - g_i)[..., None]
        S = S * jnp.exp(g_last)[..., None, None] + jnp.einsum("bhcd,bhce->bhde", k_dec, v_new)
        return S, o_i

    S_last, o = lax.scan(step, S0, (q, k, u, w, qk, gc))
    o = jnp.transpose(o, (1, 0, 3, 2, 4)).reshape(B, N * C, H, GDN_DV)[:, :T]
    return o, S_last


def gdn_branch(qkv, z, a_in, b_in, conv_buf, S0, conv_w, a_log, dt_bias, norm_w, w_o):
    B, T, _ = qkv.shape
    f32 = jnp.float32
    qkv_c, new_buf = causal_conv(qkv, conv_buf, conv_w)
    qkv_c = jax.nn.silu(qkv_c).astype(f32)
    q, k, v = jnp.split(qkv_c, [GDN_QK, 2 * GDN_QK], axis=-1)
    q = l2norm(q.reshape(B, T, GDN_HEADS, GDN_DK)) * (GDN_DK ** -0.5)
    k = l2norm(k.reshape(B, T, GDN_HEADS, GDN_DK))
    v = v.reshape(B, T, GDN_HEADS, GDN_DV)
    beta = jax.nn.sigmoid(b_in.astype(f32))
    g = -jnp.exp(a_log.astype(f32)) * jax.nn.softplus(a_in.astype(f32) + dt_bias.astype(f32))
    o, S_last = chunk_gated_delta(q, k, v, beta, g, S0.astype(f32))
    o = rmsnorm(o, norm_w) * jax.nn.silu(z.astype(f32).reshape(B, T, GDN_HEADS, GDN_DV))
    return o.reshape(B, T, GDN_V).astype(qkv.dtype) @ w_o, new_buf, S_last


def decoder_layer(x, layer_state, l, p):
    conv_rg, h_rg, s5_re, s5_im, conv_gd, s_gd = layer_state
    h = rmsnorm(x, p["norm_pre_mix"][l])
    proj = h @ p["w_in"][l]
    rg_x, rg_gate, s5_u, qkv, z, a_in, b_in, gate_logits = jnp.split(proj, split_points(), axis=-1)
    y_rg, conv_rg, h_rg = rglru_branch(rg_x, rg_gate, conv_rg, h_rg, p["rg_conv_w"][l], p["rg_conv_b"][l],
                                       p["rg_wa"][l], p["rg_ba"][l], p["rg_wx"][l], p["rg_bx"][l],
                                       p["rg_lambda"][l], p["rg_w_out"][l])
    y_s5, s5_re, s5_im = s5_branch(s5_u, s5_re, s5_im, p["s5_a_re"][l], p["s5_a_im"][l], p["s5_b_re"][l],
                                   p["s5_b_im"][l], p["s5_c_re"][l], p["s5_c_im"][l], p["s5_d"][l],
                                   p["s5_log_dt"][l], p["s5_glu_w"][l], p["s5_glu_b"][l], p["s5_w_out"][l])
    y_gd, conv_gd, s_gd = gdn_branch(qkv, z, a_in, b_in, conv_gd, s_gd, p["gdn_conv_w"][l], p["gdn_a_log"][l],
                                     p["gdn_dt_bias"][l], p["gdn_norm_w"][l], p["gdn_w_out"][l])
    g_rg, g_s5, g_gd = jnp.split(jax.nn.sigmoid(gate_logits), N_BRANCH, axis=-1)
    mixed = ((g_rg * y_rg + g_s5 * y_s5 + g_gd * y_gd).astype(x.dtype)) @ p["w_out"][l]
    x = x + rmsnorm(mixed, p["norm_post_mix"][l])
    hf = rmsnorm(x, p["norm_pre_ffn"][l])
    f = (jax.nn.silu(hf @ p["ffn_w_gate"][l]) * (hf @ p["ffn_w_up"][l])) @ p["ffn_w_down"][l]
    x = x + rmsnorm(f, p["norm_post_ffn"][l])
    return x, (conv_rg, h_rg, s5_re, s5_im, conv_gd, s_gd)


def run_stack(x, states, p):
    new = [[] for _ in states]
    for l in range(DEPTH):
        x, layer_state = decoder_layer(x, tuple(s[l] for s in states), l, p)
        for lst, s in zip(new, layer_state):
            lst.append(s)
    return x, [jnp.stack(lst) for lst in new]


def zero_states(b, dtype):
    f32 = jnp.float32
    return (jnp.zeros((DEPTH, b, CONV_W - 1, RG_WIDTH), dtype),
            jnp.zeros((DEPTH, b, RG_WIDTH), f32),
            jnp.zeros((DEPTH, b, S5_GROUPS, S5_STATE), f32),
            jnp.zeros((DEPTH, b, S5_GROUPS, S5_STATE), f32),
            jnp.zeros((DEPTH, b, CONV_W - 1, QKV_WIDTH), dtype),
            jnp.zeros((DEPTH, b, GDN_HEADS, GDN_DK, GDN_DV), f32))


def setup_inputs(seed: int = 0) -> dict:
    key = jax.random.key(seed)
    ks = iter(jax.random.split(key, 64))
    f32 = jnp.float32
    L, D = DEPTH, D_MODEL

    def nrm(shape, scale):
        return jax.random.normal(next(ks), shape, f32) * scale

    def unif(shape, lo, hi):
        return jax.random.uniform(next(ks), shape, f32, lo, hi)

    x_prompt = nrm((BATCH, SEQ, D), 1.0)
    x_sample = nrm((DEC_BATCH, DEC_SEQ, D), 1.0)
    state_rg_conv = nrm((L, DEC_BATCH, CONV_W - 1, RG_WIDTH), 1.0)
    state_rg_h = nrm((L, DEC_BATCH, RG_WIDTH), 0.5)
    state_s5_re = nrm((L, DEC_BATCH, S5_GROUPS, S5_STATE), 0.1)
    state_s5_im = nrm((L, DEC_BATCH, S5_GROUPS, S5_STATE), 0.1)
    state_gdn_conv = nrm((L, DEC_BATCH, CONV_W - 1, QKV_WIDTH), 1.0)
    state_gdn_s = nrm((L, DEC_BATCH, GDN_HEADS, GDN_DK, GDN_DV), 0.5)

    norm_pre_mix = 1.0 + nrm((L, D), 0.01)
    norm_post_mix = 1.0 + nrm((L, D), 0.01)
    norm_pre_ffn = 1.0 + nrm((L, D), 0.01)
    norm_post_ffn = 1.0 + nrm((L, D), 0.01)
    w_in = nrm((L, D, N_IN), D ** -0.5)

    rg_conv_w = nrm((L, CONV_W, RG_WIDTH), CONV_W ** -0.5)
    rg_conv_b = nrm((L, RG_WIDTH), 0.01)
    rg_wa = nrm((L, RG_BLOCKS, RG_BLOCK, RG_BLOCK), RG_BLOCK ** -0.5)
    rg_ba = nrm((L, RG_WIDTH), 0.01)
    rg_wx = nrm((L, RG_BLOCKS, RG_BLOCK, RG_BLOCK), RG_BLOCK ** -0.5)
    rg_bx = nrm((L, RG_WIDTH), 0.01)
    a_pow = unif((L, RG_WIDTH), 0.9, 0.999)
    base = a_pow ** (1.0 / RG_C)
    rg_lambda = jnp.log(base) - jnp.log1p(-base)
    rg_w_out = nrm((L, RG_WIDTH, D), RG_WIDTH ** -0.5)

    n = jnp.arange(S5_STATE, dtype=f32)
    s5_a_re = -0.5 + nrm((L, S5_GROUPS, S5_STATE), 0.01)
    s5_a_im = jnp.pi * n + nrm((L, S5_GROUPS, S5_STATE), 0.01)
    s5_b_re = nrm((L, S5_GROUPS, S5_STATE, S5_GROUP), (2 * S5_GROUP) ** -0.5)
    s5_b_im = nrm((L, S5_GROUPS, S5_STATE, S5_GROUP), (2 * S5_GROUP) ** -0.5)
    s5_c_re = nrm((L, S5_GROUPS, S5_GROUP, S5_STATE), S5_STATE ** -0.5)
    s5_c_im = nrm((L, S5_GROUPS, S5_GROUP, S5_STATE), S5_STATE ** -0.5)
    s5_d = nrm((L, S5_WIDTH), 1.0)
    s5_log_dt = unif((L, S5_GROUPS), math.log(1e-3), math.log(1e-1))
    s5_glu_w = nrm((L, S5_WIDTH, S5_WIDTH), S5_WIDTH ** -0.5)
    s5_glu_b = nrm((L, S5_WIDTH), 0.01)
    s5_w_out = nrm((L, S5_WIDTH, D), S5_WIDTH ** -0.5)

    gdn_conv_w = nrm((L, CONV_W, QKV_WIDTH), CONV_W ** -0.5)
    gdn_a_log = jnp.log(unif((L, GDN_HEADS), 1.0, 16.0))
    dt0 = jnp.exp(unif((L, GDN_HEADS), math.log(1e-3), math.log(1e-1)))
    gdn_dt_bias = dt0 + jnp.log(-jnp.expm1(-dt0))
    gdn_norm_w = 1.0 + nrm((L, GDN_DV), 0.01)
    gdn_w_out = nrm((L, GDN_V, D), GDN_V ** -0.5)

    w_out = nrm((L, D, D), D ** -0.5)
    ffn_w_gate = nrm((L, D, D_FF), D ** -0.5)
    ffn_w_up = nrm((L, D, D_FF), D ** -0.5)
    ffn_w_down = nrm((L, D_FF, D), D_FF ** -0.5)

    return {
        "x_prompt": x_prompt, "x_sample": x_sample,
        "state_rg_conv": state_rg_conv, "state_rg_h": state_rg_h,
        "state_s5_re": state_s5_re, "state_s5_im": state_s5_im,
        "state_gdn_conv": state_gdn_conv, "state_gdn_s": state_gdn_s,
        "norm_pre_mix": norm_pre_mix, "norm_post_mix": norm_post_mix,
        "norm_pre_ffn": norm_pre_ffn, "norm_post_ffn": norm_post_ffn, "w_in": w_in,
        "rg_conv_w": rg_conv_w, "rg_conv_b": rg_conv_b, "rg_wa": rg_wa, "rg_ba": rg_ba,
        "rg_wx": rg_wx, "rg_bx": rg_bx, "rg_lambda": rg_lambda, "rg_w_out": rg_w_out,
        "s5_a_re": s5_a_re, "s5_a_im": s5_a_im, "s5_b_re": s5_b_re, "s5_b_im": s5_b_im,
        "s5_c_re": s5_c_re, "s5_c_im": s5_c_im, "s5_d": s5_d, "s5_log_dt": s5_log_dt,
        "s5_glu_w": s5_glu_w, "s5_glu_b": s5_glu_b, "s5_w_out": s5_w_out,
        "gdn_conv_w": gdn_conv_w, "gdn_a_log": gdn_a_log, "gdn_dt_bias": gdn_dt_bias,
        "gdn_norm_w": gdn_norm_w, "gdn_w_out": gdn_w_out,
        "w_out": w_out, "ffn_w_gate": ffn_w_gate, "ffn_w_up": ffn_w_up, "ffn_w_down": ffn_w_down,
    }


def reference(x_prompt, x_sample, state_rg_conv, state_rg_h, state_s5_re, state_s5_im, state_gdn_conv, state_gdn_s,
              norm_pre_mix, norm_post_mix, norm_pre_ffn, norm_post_ffn, w_in,
              rg_conv_w, rg_conv_b, rg_wa, rg_ba, rg_wx, rg_bx, rg_lambda, rg_w_out,
              s5_a_re, s5_a_im, s5_b_re, s5_b_im, s5_c_re, s5_c_im, s5_d, s5_log_dt, s5_glu_w, s5_glu_b, s5_w_out,
              gdn_conv_w, gdn_a_log, gdn_dt_bias, gdn_norm_w, gdn_w_out,
              w_out, ffn_w_gate, ffn_w_up, ffn_w_down):
    p = {
        "norm_pre_mix": norm_pre_mix, "norm_post_mix": norm_post_mix,
        "norm_pre_ffn": norm_pre_ffn, "norm_post_ffn": norm_post_ffn, "w_in": w_in,
        "rg_conv_w": rg_conv_w, "rg_conv_b": rg_conv_b, "rg_wa": rg_wa, "rg_ba": rg_ba,
        "rg_wx": rg_wx, "rg_bx": rg_bx, "rg_lambda": rg_lambda, "rg_w_out": rg_w_out,
        "s5_a_re": s5_a_re, "s5_a_im": s5_a_im, "s5_b_re": s5_b_re, "s5_b_im": s5_b_im,
        "s5_c_re": s5_c_re, "s5_c_im": s5_c_im, "s5_d": s5_d, "s5_log_dt": s5_log_dt,
        "s5_glu_w": s5_glu_w, "s5_glu_b": s5_glu_b, "s5_w_out": s5_w_out,
        "gdn_conv_w": gdn_conv_w, "gdn_a_log": gdn_a_log, "gdn_dt_bias": gdn_dt_bias,
        "gdn_norm_w": gdn_norm_w, "gdn_w_out": gdn_w_out,
        "w_out": w_out, "ffn_w_gate": ffn_w_gate, "ffn_w_up": ffn_w_up, "ffn_w_down": ffn_w_down,
    }
    y_prompt, (p_rg_conv, p_rg_h, p_s5_re, p_s5_im, p_gdn_conv, p_gdn_s) = run_stack(
        x_prompt, zero_states(x_prompt.shape[0], x_prompt.dtype), p)
    y_sample, (s_rg_conv, s_rg_h, s_s5_re, s_s5_im, s_gdn_conv, s_gdn_s) = run_stack(
        x_sample, (state_rg_conv, state_rg_h, state_s5_re, state_s5_im, state_gdn_conv, state_gdn_s), p)
    return (y_prompt, y_sample,
            p_rg_conv, p_rg_h, p_s5_re, p_s5_im, p_gdn_conv, p_gdn_s,
            s_rg_conv, s_rg_h, s_s5_re, s_s5_im, s_gdn_conv, s_gdn_s)
```

```cpp
#include <hip/hip_runtime.h>
#include <hip/hip_cooperative_groups.h>
#include <cstdio>
namespace cg = cooperative_groups;

typedef unsigned short bfu;
using bf16x8 = __attribute__((ext_vector_type(8))) short;
using f32x16 = __attribute__((ext_vector_type(16))) float;
using f32x4  = __attribute__((ext_vector_type(4))) float;
using u32x4  = __attribute__((ext_vector_type(4))) unsigned;
#define DI __device__ __forceinline__
#define MFMA32(a, b, c) __builtin_amdgcn_mfma_f32_32x32x16_bf16((a), (b), (c), 0, 0, 0)
#define MFMA16(a, b, c) __builtin_amdgcn_mfma_f32_16x16x32_bf16((a), (b), (c), 0, 0, 0)

constexpr int T_ALL = 17408, TP = 16384, NPJ = 3584;
constexpr int C_RGX = 0, C_RGG = 512, C_S5U = 1024, C_QKV = 1536, C_Z = 3072;
constexpr int LDS_BYTES = 65536;

constexpr size_t O_PRC = 17825792, O_PRH = O_PRC + 24576, O_PSR = O_PRH + 8192, O_PSI = O_PSR + 32768,
                 O_PGC = O_PSI + 32768, O_PGS = O_PGC + 73728, O_SRC = O_PGS + 1048576, O_SRH = O_SRC + 393216,
                 O_SSR = O_SRH + 131072, O_SSI = O_SSR + 524288, O_SGC = O_SSI + 524288, O_SGS = O_SGC + 1179648;

constexpr size_t WS_WIN = 0;
constexpr size_t WS_RGO = WS_WIN + (size_t)6656 * 1024 * 2;
constexpr size_t WS_S5O = WS_RGO + (size_t)1024 * 512 * 2;
constexpr size_t WS_GDO = WS_S5O + (size_t)1024 * 512 * 2;
constexpr size_t WS_GLU = WS_GDO + (size_t)1024 * 512 * 2;
constexpr size_t WS_WOUT = WS_GLU + (size_t)512 * 512 * 2;
constexpr size_t WS_WGU = WS_WOUT + (size_t)1024 * 1024 * 2;
constexpr size_t WS_WDN = WS_WGU + (size_t)5632 * 1024 * 2;
constexpr size_t WS_RGW = WS_WDN + (size_t)1024 * 2816 * 2;
constexpr size_t WS_S5BB = WS_RGW + (size_t)8 * 128 * 64 * 2;
constexpr size_t WS_S5CC = WS_S5BB + (size_t)65536 * 2;
constexpr size_t WS_S5LAM = WS_S5CC + (size_t)65536 * 2;
constexpr size_t WS_H = WS_S5LAM + (size_t)4096 * 4;
constexpr size_t WS_PROJ = WS_H + (size_t)T_ALL * 1024 * 2;
constexpr size_t WS_GQG = WS_PROJ + (size_t)T_ALL * NPJ * 2;
constexpr size_t WS_GU = WS_GQG + (size_t)T_ALL * 512 * 2;
constexpr size_t WS_GW = WS_GU + (size_t)T_ALL * 512 * 2;
constexpr size_t WS_GKD = WS_GW + (size_t)T_ALL * 512 * 2;
constexpr size_t WS_GQK = WS_GKD + (size_t)272 * 4 * 128 * 64 * 2;
constexpr size_t WS_AB = WS_GQK + (size_t)272 * 4 * 64 * 64 * 2;
constexpr size_t WS_RGSUM = WS_AB + (size_t)T_ALL * 8 * 4;
constexpr size_t WS_S5SUM = WS_RGSUM + (size_t)256 * 512 * 2 * 4;
constexpr size_t WS_GDEC = WS_S5SUM + (size_t)256 * 32 * 64 * 2 * 4;
constexpr size_t WS_BAR = WS_GDEC + (size_t)272 * 4 * 32 * 4;
constexpr size_t WS_END = WS_BAR + 16384;
constexpr size_t WS_MIXED = WS_GQG, WS_MO = WS_PROJ, WS_ACT = WS_PROJ, WS_FO = WS_GQG;

struct Params {
  const float* in[41];
  float* out;
  char* ws;
};

DI int otid() { int t = threadIdx.x; asm volatile("" : "+v"(t)); return t; }
DI bfu f2bf(float x) { unsigned u = __float_as_uint(x); u += 0x7fffu + ((u >> 16) & 1u); return (bfu)(u >> 16); }
DI float bf2f(bfu v) { return __uint_as_float(((unsigned)v) << 16); }
DI unsigned pk2(float a, float b) { return (unsigned)f2bf(a) | ((unsigned)f2bf(b) << 16); }
DI float sigm(float x) { return 1.f / (1.f + __expf(-x)); }
DI float siluf(float x) { return x * sigm(x); }
DI float geluf(float x) { float u = 0.7978845608028654f * (x + 0.044715f * x * x * x); float t = __expf(2.f * u); return 0.5f * x * (2.f - 2.f / (t + 1.f)); }
DI float softplusf(float x) { return fmaxf(x, 0.f) + log1pf(__expf(-fabsf(x))); }
DI float wsum(float v) { for (int o = 32; o > 0; o >>= 1) v += __shfl_xor(v, o, 64); return v; }
DI int rowmap(int reg, int lane) { return (reg & 3) + 8 * (reg >> 2) + 4 * (lane >> 5); }

template <int MT>
DI void gemm_tile(const bfu* __restrict__ A, int lda, const bfu* __restrict__ W, int ldw, int K, f32x16 (&acc)[MT][2], char* smem) {
  constexpr int BM = 64 * MT, LS = 72;
  bfu* As = (bfu*)smem;
  bfu* Ws = As + BM * LS;
  const int tid = otid(), lane = tid & 63, wid = tid >> 6, wm = wid >> 1, wn = wid & 1;
  const int lr = tid >> 3, lc = tid & 7;
  u32x4 ra[2 * MT], rw[4];
  const bfu* Ap = A + (size_t)lr * lda + lc * 8;
  const bfu* Wp = W + (size_t)lr * ldw + lc * 8;
#pragma unroll
  for (int i = 0; i < 2 * MT; ++i) ra[i] = *(const u32x4*)(Ap + (size_t)i * 32 * lda);
#pragma unroll
  for (int i = 0; i < 4; ++i) rw[i] = *(const u32x4*)(Wp + (size_t)i * 32 * ldw);
  const int nk = K >> 6;
  const int arow = wm * 32 * MT + (lane & 31), wrow = wn * 64 + (lane & 31), kof = (lane >> 5) * 8;
  for (int kt = 0; kt < nk; ++kt) {
    __syncthreads();
#pragma unroll
    for (int i = 0; i < 2 * MT; ++i) *(u32x4*)(As + (lr + 32 * i) * LS + lc * 8) = ra[i];
#pragma unroll
    for (int i = 0; i < 4; ++i) *(u32x4*)(Ws + (lr + 32 * i) * LS + lc * 8) = rw[i];
    if (kt + 1 < nk) {
      Ap += 64; Wp += 64;
#pragma unroll
      for (int i = 0; i < 2 * MT; ++i) ra[i] = *(const u32x4*)(Ap + (size_t)i * 32 * lda);
#pragma unroll
      for (int i = 0; i < 4; ++i) rw[i] = *(const u32x4*)(Wp + (size_t)i * 32 * ldw);
    }
    __syncthreads();
#pragma unroll
    for (int ks = 0; ks < 4; ++ks) {
      bf16x8 af[MT], wf[2];
#pragma unroll
      for (int mt = 0; mt < MT; ++mt) af[mt] = *(const bf16x8*)(As + (arow + mt * 32) * LS + ks * 16 + kof);
#pragma unroll
      for (int nt = 0; nt < 2; ++nt) wf[nt] = *(const bf16x8*)(Ws + (wrow + nt * 32) * LS + ks * 16 + kof);
#pragma unroll
      for (int mt = 0; mt < MT; ++mt)
#pragma unroll
        for (int nt = 0; nt < 2; ++nt) acc[mt][nt] = MFMA32(wf[nt], af[mt], acc[mt][nt]);
    }
  }
}

template <int MT>
DI void zero_acc(f32x16 (&acc)[MT][2]) {
#pragma unroll
  for (int mt = 0; mt < MT; ++mt)
#pragma unroll
    for (int nt = 0; nt < 2; ++nt)
#pragma unroll
      for (int r = 0; r < 16; ++r) acc[mt][nt][r] = 0.f;
}

#define XB_SIMPLE 0
#define XB_CNT(j) (64 * (1 + (j)))
#define XB_XSUB(j) (64 * (17 + (j)))
#define XB_XGEN(j) (64 * (33 + (j)))
#define XB_TOP (64 * 49)
#define XB_TOPGEN (64 * 50)
#define XB_WORDS (64 * 51)
struct GBar { unsigned* w; unsigned x, nloc, nx, k; };
DI unsigned xb_ld(unsigned* p) { return __hip_atomic_load(p, __ATOMIC_RELAXED, __HIP_MEMORY_SCOPE_AGENT); }
DI unsigned xb_add(unsigned* p, unsigned v) { return __hip_atomic_fetch_add(p, v, __ATOMIC_RELAXED, __HIP_MEMORY_SCOPE_AGENT); }
DI void gbar_init(GBar& b, unsigned* w) {
  b.w = w; b.k = 0; b.nloc = 1; b.nx = 1;
  b.x = (unsigned)__builtin_amdgcn_s_getreg((3 << 11) | 20) & 0xFu;
  if (threadIdx.x == 0) {
    const unsigned r0 = xb_add(&w[XB_CNT(b.x)], 1u);
    asm volatile("s_waitcnt vmcnt(0)" ::"v"(r0) : "memory");
    xb_add(&w[XB_SIMPLE], 1u);
    while (xb_ld(&w[XB_SIMPLE]) < gridDim.x) __builtin_amdgcn_s_sleep(1);
    unsigned mine = 1u, cnt = 0u;
    for (unsigned j = 0; j < 16; ++j) { const unsigned c = xb_ld(&w[XB_CNT(j)]); cnt += (c > 0u) ? 1u : 0u; mine = (j == b.x) ? c : mine; }
    b.nloc = mine; b.nx = cnt;
  }
  __syncthreads();
}
DI void gsync(GBar& b) {
  asm volatile("s_waitcnt vmcnt(0)" ::: "memory");
  __syncthreads();
  if (threadIdx.x == 0) {
    unsigned* w = b.w;
    const unsigned gen = b.k;
    const unsigned old = xb_add(&w[XB_XSUB(b.x)], 1u);
    if (old + 1u == (gen + 1u) * b.nloc) {
      __builtin_amdgcn_fence(__ATOMIC_RELEASE, "agent");
      asm volatile("s_waitcnt vmcnt(0)" ::: "memory");
      const unsigned og = xb_add(&w[XB_TOP], 1u);
      if (og + 1u == (gen + 1u) * b.nx) xb_add(&w[XB_TOPGEN], 1u);
      else while (xb_ld(&w[XB_TOPGEN]) == gen) __builtin_amdgcn_s_sleep(1);
      __builtin_amdgcn_fence(__ATOMIC_ACQUIRE, "agent");
      xb_add(&w[XB_XGEN(b.x)], 1u);
      asm volatile("s_waitcnt vmcnt(0)" ::: "memory");
    } else {
      while (xb_ld(&w[XB_XGEN(b.x)]) == gen) __builtin_amdgcn_s_sleep(1);
      __builtin_amdgcn_fence(__ATOMIC_ACQUIRE, "agent");
      asm volatile("s_waitcnt vmcnt(0)" ::: "memory");
    }
  }
  b.k += 1;
  __syncthreads();
}

DI bool tile_map(int it, int nM, int nN, int& tm, int& tn) {
  const int ntiles = nM * nN, per = (ntiles + 7) >> 3;
  const int xcd = blockIdx.x & 7, local = (blockIdx.x >> 3) + it * (gridDim.x >> 3);
  if (local >= per) return false;
  const int q = xcd * per + local;
  if (q >= ntiles) return false;
  const int grp = q / (8 * nN), fm = grp * 8, gsz = min(nM - fm, 8), within = q - grp * 8 * nN;
  tm = fm + within % gsz; tn = within / gsz;
  return true;
}

DI void tile_of(int q, int nM, int nN, int& tm, int& tn) {
  const int grp = q / (8 * nN), fm = grp * 8, gsz = min(nM - fm, 8), within = q - grp * 8 * nN;
  tm = fm + within % gsz; tn = within / gsz;
}
template <int MT>
DI void store_tile128(f32x16 (&acc)[MT][2], bfu* C, int ldc, int m0, int n0, char* smem) {
  const int tid_ = otid(), lane = tid_ & 63, wid = tid_ >> 6, wm = wid >> 1, wn = wid & 1;
  __syncthreads();
  {
    char* cs = smem;
#pragma unroll
    for (int mt = 0; mt < MT; ++mt) {
      const int m = wm * 32 * MT + mt * 32 + (lane & 31), sw = m & 31;
#pragma unroll
      for (int nt = 0; nt < 2; ++nt)
#pragma unroll
        for (int g4 = 0; g4 < 4; ++g4) {
          const int c8 = (wn * 64 + nt * 32 + 8 * g4 + 4 * (lane >> 5)) >> 2;
          uint2 pk;
          pk.x = pk2(acc[mt][nt][4 * g4], acc[mt][nt][4 * g4 + 1]);
          pk.y = pk2(acc[mt][nt][4 * g4 + 2], acc[mt][nt][4 * g4 + 3]);
          *(uint2*)(cs + m * 256 + ((c8 ^ sw) << 3)) = pk;
        }
    }
  }
  __syncthreads();
  {
    const char* cs = smem;
    const int jj = tid_ & 15;
#pragma unroll
    for (int i = 0; i < 4 * MT; ++i) {
      const int row = (tid_ >> 4) + 16 * i, sw = row & 31;
      uint4 v = *(const uint4*)(cs + row * 256 + ((jj ^ (sw >> 1)) << 4));
      if (sw & 1) { const unsigned t0 = v.x, t1 = v.y; v.x = v.z; v.y = v.w; v.z = t0; v.w = t1; }
      *(uint4*)(C + (size_t)(m0 + row) * ldc + n0 + jj * 8) = v;
    }
  }
}
template <int MT>
DI void plain_tile(const bfu* A, int lda, const bfu* W, int ldw, int K, bfu* C, int ldc, int m0, int n0, char* smem) {
  f32x16 acc[MT][2];
  zero_acc<MT>(acc);
  gemm_tile<MT>(A + (size_t)m0 * lda, lda, W + (size_t)n0 * ldw, ldw, K, acc, smem);
  store_tile128<MT>(acc, C, ldc, m0, n0, smem);
}
DI void gemm_plain(const bfu* A, int lda, const bfu* W, int ldw, int K, int N, bfu* C, int ldc, char* smem) {
  const int nM = T_ALL / 256, nN = N / 128, ntiles = nM * nN, G = gridDim.x;
  const int rem = ntiles % G;
  const bool split = (rem > 0) && (rem * 4 <= G) && ((G & 7) == 0);
  if (!split) {
    for (int it = 0;; ++it) {
      int tm, tn;
      if (!tile_map(it, nM, nN, tm, tn)) break;
      plain_tile<4>(A, lda, W, ldw, K, C, ldc, tm * 256, tn * 128, smem);
    }
    return;
  }
  const int nfull = ntiles - rem, per = nfull >> 3;
  const int xcd = blockIdx.x & 7, slots = G >> 3;
  for (int local = blockIdx.x >> 3; local < per; local += slots) {
    int tm, tn;
    tile_of(xcd * per + local, nM, nN, tm, tn);
    plain_tile<4>(A, lda, W, ldw, K, C, ldc, tm * 256, tn * 128, smem);
  }
  for (int sidx = blockIdx.x; sidx < rem * 4; sidx += G) {
    int tm, tn;
    tile_of(nfull + (sidx >> 2), nM, nN, tm, tn);
    plain_tile<1>(A, lda, W, ldw, K, C, ldc, tm * 256 + (sidx & 3) * 64, tn * 128, smem);
  }
}

DI void gemm_glu(const Params& P, int l, char* smem) {
  bfu* PJ = (bfu*)(P.ws + WS_PROJ);
  const bfu* W = (const bfu*)(P.ws + WS_GLU);
  const float* gb = P.in[30] + l * 512;
  const int nM = T_ALL / 256, nN = 4;
  const int tid_ = otid(), lane = tid_ & 63, wid = tid_ >> 6, wm = wid >> 1, wn = wid & 1;
  for (int it = 0;; ++it) {
    int tm, tn;
    if (!tile_map(it, nM, nN, tm, tn)) break;
    f32x16 acc[4][2];
    zero_acc<4>(acc);
    gemm_tile<4>(PJ + (size_t)tm * 256 * NPJ + C_S5U, NPJ, W + (size_t)tn * 128 * 512, 512, 512, acc, smem);
#pragma unroll
    for (int mt = 0; mt < 4; ++mt) {
      const int m = tm * 256 + wm * 128 + mt * 32 + (lane & 31);
#pragma unroll
      for (int nt = 0; nt < 2; ++nt)
#pragma unroll
        for (int g4 = 0; g4 < 4; ++g4) {
          const int n = tn * 128 + wn * 64 + nt * 32 + 8 * g4 + 4 * (lane >> 5);
          const uint2 yv = *(const uint2*)(PJ + (size_t)m * NPJ + C_S5U + n);
          const float4 bv = *(const float4*)(gb + n);
          const float y0 = bf2f((bfu)(yv.x & 0xffff)), y1 = bf2f((bfu)(yv.x >> 16)), y2 = bf2f((bfu)(yv.y & 0xffff)), y3 = bf2f((bfu)(yv.y >> 16));
          uint2 pk;
          pk.x = pk2(y0 * sigm(acc[mt][nt][4 * g4] + bv.x), y1 * sigm(acc[mt][nt][4 * g4 + 1] + bv.y));
          pk.y = pk2(y2 * sigm(acc[mt][nt][4 * g4 + 2] + bv.z), y3 * sigm(acc[mt][nt][4 * g4 + 3] + bv.w));
          *(uint2*)(PJ + (size_t)m * NPJ + C_RGX + n) = pk;
        }
    }
  }
}

DI void gemm_ffn1(const Params& P, char* smem) {
  const bfu* A = (const bfu*)(P.ws + WS_H);
  const bfu* W = (const bfu*)(P.ws + WS_WGU);
  bfu* C = (bfu*)(P.ws + WS_ACT);
  const int nM = T_ALL / 256, nN = 44;
  const int tid_ = otid(), lane = tid_ & 63, wid = tid_ >> 6, wm = wid >> 1, wn = wid & 1;
  for (int it = 0;; ++it) {
    int tm, tn;
    if (!tile_map(it, nM, nN, tm, tn)) break;
    f32x16 acc[4][2];
    zero_acc<4>(acc);
    gemm_tile<4>(A + (size_t)tm * 256 * 1024, 1024, W + (size_t)tn * 128 * 1024, 1024, 1024, acc, smem);
    __syncthreads();
    {
      char* cs = smem;
#pragma unroll
      for (int mt = 0; mt < 4; ++mt) {
        const int m = wm * 128 + mt * 32 + (lane & 31), sw = m & 15;
#pragma unroll
        for (int g4 = 0; g4 < 4; ++g4) {
          const int c8 = (wn * 32 + 8 * g4 + 4 * (lane >> 5)) >> 2;
          uint2 pk;
          pk.x = pk2(siluf(acc[mt][0][4 * g4]) * acc[mt][1][4 * g4], siluf(acc[mt][0][4 * g4 + 1]) * acc[mt][1][4 * g4 + 1]);
          pk.y = pk2(siluf(acc[mt][0][4 * g4 + 2]) * acc[mt][1][4 * g4 + 2], siluf(acc[mt][0][4 * g4 + 3]) * acc[mt][1][4 * g4 + 3]);
          *(uint2*)(cs + m * 128 + ((c8 ^ sw) << 3)) = pk;
        }
      }
    }
    __syncthreads();
    {
      const char* cs = smem;
      const int jj = tid_ & 7;
#pragma unroll
      for (int i = 0; i < 8; ++i) {
        const int row = (tid_ >> 3) + 32 * i, sw = row & 15;
        uint4 v = *(const uint4*)(cs + row * 128 + ((jj ^ (sw >> 1)) << 4));
        if (sw & 1) { const unsigned t0 = v.x, t1 = v.y; v.x = v.z; v.y = v.w; v.z = t0; v.w = t1; }
        *(uint4*)(C + (size_t)(tm * 256 + row) * 2816 + tn * 64 + jj * 8) = v;
      }
    }
  }
}

template <int MT>
DI void merge_tile(const Params& P, int m0, int tn, char* smem) {
  const bfu* H = (const bfu*)(P.ws + WS_H);
  const bfu* PJ = (const bfu*)(P.ws + WS_PROJ);
  const bfu* WIN = (const bfu*)(P.ws + WS_WIN);
  bfu* C = (bfu*)(P.ws + WS_MIXED);
  const int tid_ = otid(), lane = tid_ & 63, wid = tid_ >> 6, wm = wid >> 1, wn = wid & 1;
  f32x16 tot[MT][2];
  zero_acc<MT>(tot);
#pragma unroll 1
  for (int b = 0; b < 3; ++b) {
    unsigned* gps = (unsigned*)(smem + 36864) + tid_;
    unsigned gkeep[4] = {0u, 0u, 0u, 0u};
    {
      f32x16 g[MT][2];
      zero_acc<MT>(g);
      gemm_tile<MT>(H + (size_t)m0 * 1024, 1024, WIN + (size_t)(3584 + b * 1024 + tn * 128) * 1024, 1024, 1024, g, smem);
#pragma unroll
      for (int mt = 0; mt < MT; ++mt)
#pragma unroll
        for (int nt = 0; nt < 2; ++nt)
#pragma unroll
          for (int r = 0; r < 8; ++r) {
            const unsigned pv = pk2(sigm(g[mt][nt][2 * r]), sigm(g[mt][nt][2 * r + 1]));
            if ((mt * 2 + nt) * 8 + r < 28) gps[((mt * 2 + nt) * 8 + r) * 256] = pv;
            else gkeep[((mt * 2 + nt) * 8 + r) - 28] = pv;
          }
    }
    const int colb = (b == 0) ? C_RGG : (b == 1 ? C_RGX : C_Z);
    const bfu* Wo = (const bfu*)(P.ws + (b == 0 ? WS_RGO : (b == 1 ? WS_S5O : WS_GDO)));
    f32x16 y[MT][2];
    zero_acc<MT>(y);
    gemm_tile<MT>(PJ + (size_t)m0 * NPJ + colb, NPJ, Wo + (size_t)tn * 128 * 512, 512, 512, y, smem);
#pragma unroll
    for (int mt = 0; mt < MT; ++mt)
#pragma unroll
      for (int nt = 0; nt < 2; ++nt)
#pragma unroll
        for (int r = 0; r < 8; ++r) {
          const unsigned gv = ((mt * 2 + nt) * 8 + r < 28) ? gps[((mt * 2 + nt) * 8 + r) * 256] : gkeep[((mt * 2 + nt) * 8 + r) - 28];
          tot[mt][nt][2 * r] += __uint_as_float(gv << 16) * y[mt][nt][2 * r];
          tot[mt][nt][2 * r + 1] += __uint_as_float(gv & 0xffff0000u) * y[mt][nt][2 * r + 1];
        }
  }
  store_tile128<MT>(tot, C, 1024, m0, tn * 128, smem);
}
DI void gemm_merge(const Params& P, char* smem) {
  const int nM = T_ALL / 128, nN = 8, ntiles = nM * nN, G = gridDim.x;
  const int rem = ntiles % G;
  const bool split = (rem > 0) && (rem * 2 <= G / 2) && ((G & 7) == 0);
  if (!split) {
    for (int it = 0;; ++it) {
      int tm, tn;
      if (!tile_map(it, nM, nN, tm, tn)) break;
      merge_tile<2>(P, tm * 128, tn, smem);
    }
    return;
  }
  const int nfull = ntiles - rem, per = nfull >> 3;
  const int xcd = blockIdx.x & 7, slots = G >> 3;
  for (int local = blockIdx.x >> 3; local < per; local += slots) {
    int tm, tn;
    tile_of(xcd * per + local, nM, nN, tm, tn);
    merge_tile<2>(P, tm * 128, tn, smem);
  }
  for (int sidx = blockIdx.x; sidx < rem * 2; sidx += G) {
    int tm, tn;
    tile_of(nfull + (sidx >> 1), nM, nN, tm, tn);
    merge_tile<1>(P, tm * 128 + (sidx & 1) * 64, tn, smem);
  }
}

DI void cvt_job(const float* src, int ld, int K, int ncols, bfu* dst, int ldd, int mode, float* sm) {
  const int nkt = K >> 6, nnt = ncols >> 6, nt = nkt * nnt;
  const int tid = otid();
  for (int t = blockIdx.x; t < nt; t += gridDim.x) {
    const int kt = t % nkt, ct = t / nkt;
    const int k0 = kt * 64, c0 = ct * 64;
    float4 v[4];
#pragma unroll
    for (int i = 0; i < 4; ++i) v[i] = *(const float4*)(src + (size_t)(k0 + (tid >> 4) + 16 * i) * ld + c0 + (tid & 15) * 4);
    __syncthreads();
#pragma unroll
    for (int i = 0; i < 4; ++i) {
      const int k = (tid >> 4) + 16 * i, n = (tid & 15) * 4;
      sm[(n + 0) * 65 + k] = v[i].x; sm[(n + 1) * 65 + k] = v[i].y; sm[(n + 2) * 65 + k] = v[i].z; sm[(n + 3) * 65 + k] = v[i].w;
    }
    __syncthreads();
    const int n = tid >> 2, ks = (tid & 3) * 16;
    const int row = (mode == 0) ? (c0 + n) : (ct * 128 + (n >> 5) * 64 + (mode - 1) * 32 + (n & 31));
    uint4 w0, w1;
    const float* r = sm + n * 65 + ks;
    w0.x = pk2(r[0], r[1]); w0.y = pk2(r[2], r[3]); w0.z = pk2(r[4], r[5]); w0.w = pk2(r[6], r[7]);
    w1.x = pk2(r[8], r[9]); w1.y = pk2(r[10], r[11]); w1.z = pk2(r[12], r[13]); w1.w = pk2(r[14], r[15]);
    *(uint4*)(dst + (size_t)row * ldd + k0 + ks) = w0;
    *(uint4*)(dst + (size_t)row * ldd + k0 + ks + 8) = w1;
  }
}

DI void prep_layer(const Params& P, int l, char* smem) {
  float* sm = (float*)smem;
  char* ws = P.ws;
  cvt_job(P.in[12] + (size_t)l * 1024 * 6664, 6664, 1024, 3584, (bfu*)(ws + WS_WIN), 1024, 0, sm);
  cvt_job(P.in[12] + (size_t)l * 1024 * 6664 + 3592, 6664, 1024, 3072, (bfu*)(ws + WS_WIN) + (size_t)3584 * 1024, 1024, 0, sm);
  cvt_job(P.in[20] + (size_t)l * 512 * 1024, 1024, 512, 1024, (bfu*)(ws + WS_RGO), 512, 0, sm);
  cvt_job(P.in[31] + (size_t)l * 512 * 1024, 1024, 512, 1024, (bfu*)(ws + WS_S5O), 512, 0, sm);
  cvt_job(P.in[36] + (size_t)l * 512 * 1024, 1024, 512, 1024, (bfu*)(ws + WS_GDO), 512, 0, sm);
  cvt_job(P.in[29] + (size_t)l * 512 * 512, 512, 512, 512, (bfu*)(ws + WS_GLU), 512, 0, sm);
  cvt_job(P.in[37] + (size_t)l * 1024 * 1024, 1024, 1024, 1024, (bfu*)(ws + WS_WOUT), 1024, 0, sm);
  cvt_job(P.in[38] + (size_t)l * 1024 * 2816, 2816, 1024, 2816, (bfu*)(ws + WS_WGU), 1024, 1, sm);
  cvt_job(P.in[39] + (size_t)l * 1024 * 2816, 2816, 1024, 2816, (bfu*)(ws + WS_WGU), 1024, 2, sm);
  cvt_job(P.in[40] + (size_t)l * 2816 * 1024, 1024, 2816, 1024, (bfu*)(ws + WS_WDN), 2816, 0, sm);
#pragma unroll 1
  for (int n = 0; n < 8; ++n) {
    cvt_job(P.in[15] + (size_t)(l * 8 + n) * 4096, 64, 64, 64, (bfu*)(ws + WS_RGW) + (size_t)n * 8192, 64, 0, sm);
    cvt_job(P.in[17] + (size_t)(l * 8 + n) * 4096, 64, 64, 64, (bfu*)(ws + WS_RGW) + (size_t)n * 8192 + 4096, 64, 0, sm);
  }
  bfu* BB = (bfu*)(ws + WS_S5BB);
  bfu* CC = (bfu*)(ws + WS_S5CC);
  float* LAM = (float*)(ws + WS_S5LAM);
  for (int idx = blockIdx.x * 256 + otid(); idx < 2048; idx += gridDim.x * 256) {
    const int g = idx >> 6, p = idx & 63;
    const float ar = P.in[21][l * 2048 + idx], ai = P.in[22][l * 2048 + idx];
    const float dt = expf(P.in[28][l * 32 + g]);
    const float mag = expf(ar * dt), ang = ai * dt;
    const float lr = mag * cosf(ang), li = mag * sinf(ang);
    LAM[idx * 2] = lr; LAM[idx * 2 + 1] = li;
    const float den = 1.f / (ar * ar + ai * ai);
    const float cr = ((lr - 1.f) * ar + li * ai) * den, ci = (li * ar - (lr - 1.f) * ai) * den;
    const float* bre = P.in[23] + ((size_t)(l * 32 + g) * 64 + p) * 16;
    const float* bim = P.in[24] + ((size_t)(l * 32 + g) * 64 + p) * 16;
    for (int h = 0; h < 16; ++h) {
      const float br = bre[h], bi = bim[h];
      BB[(size_t)(g * 128 + p) * 16 + h] = f2bf(cr * br - ci * bi);
      BB[(size_t)(g * 128 + 64 + p) * 16 + h] = f2bf(cr * bi + ci * br);
      CC[(size_t)(g * 16 + h) * 128 + p] = f2bf(P.in[25][((size_t)(l * 32 + g) * 16 + h) * 64 + p]);
      CC[(size_t)(g * 16 + h) * 128 + 64 + p] = f2bf(-P.in[26][((size_t)(l * 32 + g) * 16 + h) * 64 + p]);
    }
  }
}

DI void norm_pass(const Params& P, int l, int mode, char* smem) {
  const int tid_ = otid(), lane = tid_ & 63, wid = tid_ >> 6;
  const int nw = gridDim.x * 4, gw = blockIdx.x * 4 + wid;
  const bfu* src = (const bfu*)(P.ws + (mode == 1 ? WS_MO : WS_FO));
  const float* gA = (mode == 1 ? P.in[9] : P.in[11]) + l * 1024;
  const bool doH = (mode != 2) || (l == 0);
  const float* gB = (mode == 0) ? P.in[8] : (mode == 1 ? P.in[10] + l * 1024 : P.in[8] + 1024);
  const bool doAB = (mode == 0) || (mode == 2 && l == 0);
  const int lab = (mode == 0) ? 0 : 1;
  const float* W8 = P.in[12] + (size_t)lab * 1024 * 6664 + 3584;
  bfu* H = (bfu*)(P.ws + WS_H);
  float* AB = (float*)(P.ws + WS_AB);
  float* W8s = (float*)smem;
  if (doAB) {
    __syncthreads();
    for (int idx = tid_; idx < 8192; idx += 256) W8s[(idx & 7) * 1024 + (idx >> 3)] = W8[(size_t)(idx >> 3) * 6664 + (idx & 7)];
    __syncthreads();
  }
  for (int r = gw; r < T_ALL; r += nw) {
    float4 xv[4];
    float* xo = P.out + (size_t)r * 1024;
    if (mode == 0) {
      const float* xi = (r < TP) ? (P.in[0] + (size_t)r * 1024) : (P.in[1] + (size_t)(r - TP) * 1024);
#pragma unroll
      for (int i = 0; i < 4; ++i) xv[i] = *(const float4*)(xi + lane * 4 + 256 * i);
    } else {
      float4 av[4];
      float ss = 0.f;
#pragma unroll
      for (int i = 0; i < 4; ++i) {
        xv[i] = *(const float4*)(xo + lane * 4 + 256 * i);
        const uint2 s2 = *(const uint2*)(src + (size_t)r * 1024 + lane * 4 + 256 * i);
        av[i].x = bf2f((bfu)(s2.x & 0xffff)); av[i].y = bf2f((bfu)(s2.x >> 16));
        av[i].z = bf2f((bfu)(s2.y & 0xffff)); av[i].w = bf2f((bfu)(s2.y >> 16));
        ss += av[i].x * av[i].x + av[i].y * av[i].y + av[i].z * av[i].z + av[i].w * av[i].w;
      }
      ss = wsum(ss);
      const float sa = rsqrtf(ss * (1.f / 1024.f) + 1e-6f);
#pragma unroll
      for (int i = 0; i < 4; ++i) {
        const float4 gv = *(const float4*)(gA + lane * 4 + 256 * i);
        xv[i].x += av[i].x * sa * gv.x; xv[i].y += av[i].y * sa * gv.y;
        xv[i].z += av[i].z * sa * gv.z; xv[i].w += av[i].w * sa * gv.w;
      }
    }
#pragma unroll
    for (int i = 0; i < 4; ++i) *(float4*)(xo + lane * 4 + 256 * i) = xv[i];
    if (doH) {
      float ss = 0.f;
#pragma unroll
      for (int i = 0; i < 4; ++i) ss += xv[i].x * xv[i].x + xv[i].y * xv[i].y + xv[i].z * xv[i].z + xv[i].w * xv[i].w;
      ss = wsum(ss);
      const float sc = rsqrtf(ss * (1.f / 1024.f) + 1e-6f);
      float ab[8];
#pragma unroll
      for (int j = 0; j < 8; ++j) ab[j] = 0.f;
#pragma unroll
      for (int i = 0; i < 4; ++i) {
        const float4 gv = *(const float4*)(gB + lane * 4 + 256 * i);
        float hv[4] = {xv[i].x * sc * gv.x, xv[i].y * sc * gv.y, xv[i].z * sc * gv.z, xv[i].w * sc * gv.w};
        uint2 pk;
        pk.x = pk2(hv[0], hv[1]); pk.y = pk2(hv[2], hv[3]);
        *(uint2*)(H + (size_t)r * 1024 + lane * 4 + 256 * i) = pk;
        if (doAB) {
#pragma unroll
          for (int j = 0; j < 8; ++j) {
            const float4 wj = *(const float4*)(W8s + j * 1024 + lane * 4 + 256 * i);
            ab[j] += hv[0] * wj.x; ab[j] += hv[1] * wj.y; ab[j] += hv[2] * wj.z; ab[j] += hv[3] * wj.w;
          }
        }
      }
      if (doAB) {
#pragma unroll
        for (int j = 0; j < 8; ++j) ab[j] = wsum(ab[j]);
        if (lane == 0) {
          *(float4*)(AB + (size_t)r * 8) = make_float4(ab[0], ab[1], ab[2], ab[3]);
          *(float4*)(AB + (size_t)r * 8 + 4) = make_float4(ab[4], ab[5], ab[6], ab[7]);
        }
      }
    }
  }
}

DI void rg_task(const Params& P, int l, int chunk, int n, int mode, char* smem) {
  float* xc_f = (float*)smem;
  bfu* xc_b = (bfu*)(xc_f + 64 * 65);
  float* a_s = (float*)(xc_b + 64 * 72);
  float* in_s = a_s + 4096;
  float* segP = in_s + 4096;
  float* segH = segP + 512;
  float* car = segH + 512;
  float* part = car + 64;
  const int tid = otid(), lane = tid & 63, wid = tid >> 6;
  bfu* PJ = (bfu*)(P.ws + WS_PROJ);
  const int tok0 = chunk * 64;
  const bool isS = chunk >= 256;
  const int c = tid & 63, tq = tid >> 6, cc = n * 64 + c;
  const bfu* RGW = (const bfu*)(P.ws + WS_RGW) + (size_t)n * 8192;
  bf16x8 wbr[4], wbi[4];
#pragma unroll
  for (int ks = 0; ks < 4; ++ks) {
    wbr[ks] = *(const bf16x8*)(RGW + ((wid & 1) * 32 + (lane & 31)) * 64 + ks * 16 + (lane >> 5) * 8);
    wbi[ks] = *(const bf16x8*)(RGW + (64 + (wid & 1) * 32 + (lane & 31)) * 64 + ks * 16 + (lane >> 5) * 8);
  }
  const int cch0 = n * 64 + (wid & 1) * 32 + (lane & 31);
  const float ba = P.in[16][l * 512 + cch0], bx = P.in[18][l * 512 + cch0];
  const float sp = softplusf(-P.in[19][l * 512 + cch0]);
  float gt2[2][8];
  float2 rprev[8];
  float* RGSUM = (float*)(P.ws + WS_RGSUM);
  if (mode != 0) {
#pragma unroll
    for (int q = 0; q < 2; ++q)
#pragma unroll
      for (int tt = 0; tt < 8; ++tt) gt2[q][tt] = bf2f(PJ[(size_t)(tok0 + (tq + 4 * q) * 8 + tt) * NPJ + C_RGG + cc]);
    if (!isS) {
      const int ci = chunk & 31, cs = chunk & ~31;
#pragma unroll
      for (int i = 0; i < 8; ++i) {
        const int c2 = tq * 8 + i;
        rprev[i] = (c2 < ci) ? *(const float2*)(RGSUM + ((size_t)(cs + c2) * 512 + cc) * 2) : make_float2(1.f, 0.f);
      }
    }
  }
  {
    const float* cw = P.in[13] + l * 2048;
    const float w0 = cw[cc], w1 = cw[512 + cc], w2 = cw[1024 + cc], w3 = cw[1536 + cc], cb = P.in[14][l * 512 + cc];
    if (!isS) {
      bfu* xs = (bfu*)a_s;
      const bool first = (chunk & 31) == 0;
#pragma unroll
      for (int j = 0; j < 3; ++j) {
        const int idx = tid + 256 * j;
        if (idx < 67 * 8) {
          const int row = idx >> 3, ch = idx & 7;
          u32x4 v = {0u, 0u, 0u, 0u};
          if (!(first && row < 3)) v = *(const u32x4*)(PJ + (size_t)(tok0 - 3 + row) * NPJ + C_RGX + n * 64 + ch * 8);
          *(u32x4*)(xs + row * 64 + ch * 8) = v;
        }
      }
      __syncthreads();
#pragma unroll 4
      for (int i = 0; i < 16; ++i) {
        const int t = tq + 4 * i;
        const float acc = cb + w0 * bf2f(xs[t * 64 + c]) + w1 * bf2f(xs[(t + 1) * 64 + c]) + w2 * bf2f(xs[(t + 2) * 64 + c]) + w3 * bf2f(xs[(t + 3) * 64 + c]);
        xc_f[t * 65 + c] = acc;
        xc_b[t * 72 + c] = f2bf(acc);
      }
    } else {
#pragma unroll 4
      for (int i = 0; i < 16; ++i) {
        const int t = tq + 4 * i, tok = tok0 + t, tl = tok & 7;
        float xk[4];
#pragma unroll
        for (int k = 0; k < 4; ++k) {
          const int j = tl + k - 3;
          if (j >= 0) xk[k] = bf2f(PJ[(size_t)(tok + k - 3) * NPJ + C_RGX + cc]);
          else xk[k] = P.in[2][((size_t)(l * 128 + ((tok - TP) >> 3)) * 3 + (tl + k)) * 512 + cc];
        }
        const float acc = cb + w0 * xk[0] + w1 * xk[1] + w2 * xk[2] + w3 * xk[3];
        xc_f[t * 65 + c] = acc;
        xc_b[t * 72 + c] = f2bf(acc);
      }
    }
  }
  __syncthreads();
  {
    const int mt = wid >> 1, ntl = wid & 1;
    f32x16 R, I;
#pragma unroll
    for (int r = 0; r < 16; ++r) { R[r] = 0.f; I[r] = 0.f; }
#pragma unroll
    for (int ks = 0; ks < 4; ++ks) {
      const bf16x8 a = *(const bf16x8*)(xc_b + (mt * 32 + (lane & 31)) * 72 + ks * 16 + (lane >> 5) * 8);
      R = MFMA32(a, wbr[ks], R);
      I = MFMA32(a, wbi[ks], I);
    }
    const int ch = ntl * 32 + (lane & 31);
#pragma unroll
    for (int r = 0; r < 16; ++r) {
      const int t = mt * 32 + rowmap(r, lane);
      const float rr = sigm(R[r] + ba), ig = sigm(I[r] + bx);
      const float la = -8.f * rr * sp;
      const float a = __expf(la);
      const float inp = sqrtf(fmaxf(-expm1f(2.f * la), 0.f)) * ig * xc_f[t * 65 + ch];
      a_s[t * 64 + ch] = a;
      in_s[t * 64 + ch] = inp;
    }
  }
  __syncthreads();
#pragma unroll
  for (int q = 0; q < 2; ++q) {
    const int sg = tq + 4 * q;
    float Pp = 1.f, Hh = 0.f;
#pragma unroll
    for (int tt = 0; tt < 8; ++tt) {
      const float a = a_s[(sg * 8 + tt) * 64 + c];
      Hh = a * Hh + in_s[(sg * 8 + tt) * 64 + c];
      Pp *= a;
    }
    segP[sg * 64 + c] = Pp; segH[sg * 64 + c] = Hh;
  }
  __syncthreads();
  if (mode == 0) {
    if (tid < 64) {
      float Pp = 1.f, Hh = 0.f;
#pragma unroll
      for (int sg = 0; sg < 8; ++sg) { Hh = segP[sg * 64 + c] * Hh + segH[sg * 64 + c]; Pp *= segP[sg * 64 + c]; }
      *(float2*)(RGSUM + ((size_t)chunk * 512 + cc) * 2) = make_float2(Pp, Hh);
    }
    return;
  }
  if (!isS) {
    const int ci = chunk & 31, cs = chunk & ~31;
    float Pp = 1.f, Hh = 0.f;
#pragma unroll
    for (int i = 0; i < 8; ++i) {
      const int c2 = tq * 8 + i;
      if (c2 < ci) {
        const float2 ph = rprev[i];
        Hh = ph.x * Hh + ph.y; Pp *= ph.x;
      }
    }
    part[(tq * 64 + c) * 2] = Pp; part[(tq * 64 + c) * 2 + 1] = Hh;
    __syncthreads();
    if (tid < 64) {
      float h = 0.f;
#pragma unroll
      for (int q2 = 0; q2 < 4; ++q2) h = part[(q2 * 64 + c) * 2] * h + part[(q2 * 64 + c) * 2 + 1];
      car[c] = h;
    }
    __syncthreads();
  }
#pragma unroll
  for (int q = 0; q < 2; ++q) {
    const int sg = tq + 4 * q;
    float h;
    const int sseq = (tok0 - TP) / 8 + sg;
    if (isS) h = P.in[3][(size_t)(l * 128 + sseq) * 512 + cc];
    else {
      h = car[c];
      for (int s2 = 0; s2 < sg; ++s2) h = segP[s2 * 64 + c] * h + segH[s2 * 64 + c];
    }
#pragma unroll
    for (int tt = 0; tt < 8; ++tt) {
      const int t = sg * 8 + tt;
      h = a_s[t * 64 + c] * h + in_s[t * 64 + c];
      PJ[(size_t)(tok0 + t) * NPJ + C_RGG + cc] = f2bf(h * geluf(gt2[q][tt]));
    }
    if (isS) P.out[O_SRH + (size_t)(l * 128 + sseq) * 512 + cc] = h;
    else if ((chunk & 31) == 31 && sg == 7) P.out[O_PRH + (size_t)(l * 8 + (chunk >> 5)) * 512 + cc] = h;
  }
  if (isS) {
    for (int idx = tid; idx < 8 * 3 * 64; idx += 256) {
      const int c3 = idx & 63, i = (idx >> 6) % 3, sg = idx / 192;
      const int sseq = (tok0 - TP) / 8 + sg;
      P.out[O_SRC + ((size_t)(l * 128 + sseq) * 3 + i) * 512 + n * 64 + c3] = bf2f(PJ[(size_t)(tok0 + sg * 8 + 5 + i) * NPJ + C_RGX + n * 64 + c3]);
    }
  } else if ((chunk & 31) == 31) {
    if (tid < 192) {
      const int c3 = tid & 63, i = tid >> 6;
      P.out[O_PRC + ((size_t)(l * 8 + (chunk >> 5)) * 3 + i) * 512 + n * 64 + c3] = bf2f(PJ[(size_t)(tok0 + 61 + i) * NPJ + C_RGX + n * 64 + c3]);
    }
  }
}

DI void s5_task(const Params& P, int l, int chunk, int g, int mode, char* smem) {
  float* bu_s = (float*)smem;
  bfu* ss_b = (bfu*)(bu_s + 8192);
  float* segS = (float*)(ss_b + 64 * 136);
  float* car = segS + 1024;
  float* part = car + 128;
  const int tid = otid(), lane = tid & 63, wid = tid >> 6;
  bfu* PJ = (bfu*)(P.ws + WS_PROJ);
  const int tok0 = chunk * 64;
  const bool isS = chunk >= 256;
  const int p = tid & 63, tq = tid >> 6;
  const float* LAMT = (const float*)(P.ws + WS_S5LAM);
  const float lr = LAMT[(g * 64 + p) * 2], li = LAMT[(g * 64 + p) * 2 + 1];
  float* S5SUM = (float*)(P.ws + WS_S5SUM);
  bf16x8 cfr[4];
  float2 sprev[8];
  float uu[4], st0[4];
  const int hh = lane & 15;
  const float dco = P.in[27][l * 512 + g * 16 + hh];
  if (mode != 0) {
    const bfu* CC = (const bfu*)(P.ws + WS_S5CC) + (size_t)g * 2048;
#pragma unroll
    for (int ks = 0; ks < 4; ++ks) cfr[ks] = *(const bf16x8*)(CC + (lane & 15) * 128 + ks * 32 + (lane >> 4) * 8);
#pragma unroll
    for (int r = 0; r < 4; ++r) uu[r] = bf2f(PJ[(size_t)(tok0 + wid * 16 + (lane >> 4) * 4 + r) * NPJ + C_S5U + g * 16 + hh]);
    if (!isS) {
      const int ci = chunk & 31, cs = chunk & ~31;
#pragma unroll
      for (int i = 0; i < 8; ++i) {
        const int c2 = tq * 8 + i;
        sprev[i] = (c2 < ci) ? *(const float2*)(S5SUM + (((size_t)(cs + c2) * 32 + g) * 64 + p) * 2) : make_float2(0.f, 0.f);
      }
    } else {
#pragma unroll
      for (int q = 0; q < 2; ++q) {
        const size_t si0 = ((size_t)(l * 128 + (tok0 - TP) / 8 + tq + 4 * q) * 32 + g) * 64 + p;
        st0[2 * q] = P.in[4][si0]; st0[2 * q + 1] = P.in[5][si0];
      }
    }
  }
  {
    const bfu* BB = (const bfu*)(P.ws + WS_S5BB) + (size_t)g * 2048;
    const bf16x8 b = *(const bf16x8*)(BB + (wid * 32 + (lane & 31)) * 16 + (lane >> 5) * 8);
#pragma unroll
    for (int mt = 0; mt < 2; ++mt) {
      const bf16x8 a = *(const bf16x8*)(PJ + (size_t)(tok0 + mt * 32 + (lane & 31)) * NPJ + C_S5U + g * 16 + (lane >> 5) * 8);
      f32x16 d;
#pragma unroll
      for (int r = 0; r < 16; ++r) d[r] = 0.f;
      d = MFMA32(a, b, d);
#pragma unroll
      for (int r = 0; r < 16; ++r) bu_s[(mt * 32 + rowmap(r, lane)) * 128 + wid * 32 + (lane & 31)] = d[r];
    }
  }
  __syncthreads();
#pragma unroll
  for (int q = 0; q < 2; ++q) {
    const int sg = tq + 4 * q;
    float sr = 0.f, si = 0.f;
#pragma unroll
    for (int tt = 0; tt < 8; ++tt) {
      const int t = sg * 8 + tt;
      const float nr = lr * sr - li * si + bu_s[t * 128 + p];
      const float ni = lr * si + li * sr + bu_s[t * 128 + 64 + p];
      sr = nr; si = ni;
    }
    segS[(sg * 64 + p) * 2] = sr; segS[(sg * 64 + p) * 2 + 1] = si;
  }
  __syncthreads();
  float l8r = lr, l8i = li;
#pragma unroll
  for (int k = 0; k < 3; ++k) { const float nr = l8r * l8r - l8i * l8i, ni = 2.f * l8r * l8i; l8r = nr; l8i = ni; }
  if (mode == 0) {
    if (tid < 64) {
      float sr = 0.f, si = 0.f;
#pragma unroll
      for (int sg = 0; sg < 8; ++sg) {
        const float nr = l8r * sr - l8i * si + segS[(sg * 64 + p) * 2];
        const float ni = l8r * si + l8i * sr + segS[(sg * 64 + p) * 2 + 1];
        sr = nr; si = ni;
      }
      *(float2*)(S5SUM + (((size_t)chunk * 32 + g) * 64 + p) * 2) = make_float2(sr, si);
    }
    return;
  }
  if (!isS) {
    float l64r = l8r, l64i = l8i;
#pragma unroll
    for (int k = 0; k < 3; ++k) { const float nr = l64r * l64r - l64i * l64i, ni = 2.f * l64r * l64i; l64r = nr; l64i = ni; }
    const int ci = chunk & 31, cs = chunk & ~31;
    float ar = 0.f, ai = 0.f;
#pragma unroll
    for (int i = 0; i < 8; ++i) {
      const int c2 = tq * 8 + i;
      if (c2 < ci) {
        const float2 sv = sprev[i];
        const float nr = l64r * ar - l64i * ai + sv.x, ni = l64r * ai + l64i * ar + sv.y;
        ar = nr; ai = ni;
      }
    }
    part[(tq * 64 + p) * 2] = ar; part[(tq * 64 + p) * 2 + 1] = ai;
    __syncthreads();
    if (tid < 64) {
      float cr = 0.f, cim = 0.f;
      for (int q2 = 0; q2 < 4; ++q2) {
        const int cnt = min(max(ci - q2 * 8, 0), 8);
        for (int k = 0; k < cnt; ++k) { const float nr = l64r * cr - l64i * cim, ni = l64r * cim + l64i * cr; cr = nr; cim = ni; }
        cr += part[(q2 * 64 + p) * 2]; cim += part[(q2 * 64 + p) * 2 + 1];
      }
      car[p * 2] = cr; car[p * 2 + 1] = cim;
    }
    __syncthreads();
  }
#pragma unroll
  for (int q = 0; q < 2; ++q) {
    const int sg = tq + 4 * q;
    const int sseq = (tok0 - TP) / 8 + sg;
    float sr, si;
    if (isS) {
      sr = st0[2 * q]; si = st0[2 * q + 1];
    } else {
      sr = car[p * 2]; si = car[p * 2 + 1];
      for (int s2 = 0; s2 < sg; ++s2) {
        const float nr = l8r * sr - l8i * si + segS[(s2 * 64 + p) * 2];
        const float ni = l8r * si + l8i * sr + segS[(s2 * 64 + p) * 2 + 1];
        sr = nr; si = ni;
      }
    }
#pragma unroll
    for (int tt = 0; tt < 8; ++tt) {
      const int t = sg * 8 + tt;
      const float nr = lr * sr - li * si + bu_s[t * 128 + p];
      const float ni = lr * si + li * sr + bu_s[t * 128 + 64 + p];
      sr = nr; si = ni;
      ss_b[t * 136 + p] = f2bf(sr);
      ss_b[t * 136 + 64 + p] = f2bf(si);
    }
    if (isS) {
      const size_t so = ((size_t)(l * 128 + sseq) * 32 + g) * 64 + p;
      P.out[O_SSR + so] = sr; P.out[O_SSI + so] = si;
    } else if ((chunk & 31) == 31 && sg == 7) {
      const size_t so = ((size_t)(l * 8 + (chunk >> 5)) * 32 + g) * 64 + p;
      P.out[O_PSR + so] = sr; P.out[O_PSI + so] = si;
    }
  }
  __syncthreads();
  {
    f32x4 acc = {0.f, 0.f, 0.f, 0.f};
#pragma unroll
    for (int ks = 0; ks < 4; ++ks) {
      const bf16x8 a = *(const bf16x8*)(ss_b + (wid * 16 + (lane & 15)) * 136 + ks * 32 + (lane >> 4) * 8);
      acc = MFMA16(a, cfr[ks], acc);
    }
    const int h = hh;
#pragma unroll
    for (int r = 0; r < 4; ++r) {
      const int t = wid * 16 + (lane >> 4) * 4 + r;
      PJ[(size_t)(tok0 + t) * NPJ + C_S5U + g * 16 + h] = f2bf(geluf(acc[r] + dco * uu[r]));
    }
  }
}

DI void gdn_conv_col(const Params& P, int l, int chunk, int ch, float (&v)[64]) {
  const bfu* PJ = (const bfu*)(P.ws + WS_PROJ);
  const int tok0 = chunk * 64;
  const bool isS = chunk >= 256;
  const float* cw = P.in[32] + l * 4 * 1536;
  const float w0 = cw[ch], w1 = cw[1536 + ch], w2 = cw[2 * 1536 + ch], w3 = cw[3 * 1536 + ch];
  float x3 = 0.f, x2 = 0.f, x1 = 0.f;
  if (!isS && (chunk & 31) != 0) {
    x3 = bf2f(PJ[(size_t)(tok0 - 3) * NPJ + C_QKV + ch]);
    x2 = bf2f(PJ[(size_t)(tok0 - 2) * NPJ + C_QKV + ch]);
    x1 = bf2f(PJ[(size_t)(tok0 - 1) * NPJ + C_QKV + ch]);
  }
#pragma unroll
  for (int sg = 0; sg < 8; ++sg) {
    if (isS) {
      const float* st = P.in[6] + ((size_t)(l * 128 + (chunk - 256) * 8 + sg) * 3) * 1536 + ch;
      x3 = st[0]; x2 = st[1536]; x1 = st[2 * 1536];
    }
#pragma unroll
    for (int tt = 0; tt < 8; ++tt) {
      const int t = sg * 8 + tt;
      const float x = bf2f(PJ[(size_t)(tok0 + t) * NPJ + C_QKV + ch]);
      v[t] = siluf(w0 * x3 + w1 * x2 + w2 * x1 + w3 * x);
      x3 = x2; x2 = x1; x1 = x;
    }
  }
}

DI void gdn1_task(const Params& P, int l, int chunk, int head, char* smem) {
  bfu* qn_b = (bfu*)smem;
  bfu* kn_b = qn_b + 64 * 136;
  float* L_s = (float*)(kn_b + 64 * 136);
  float* rq = L_s + 4096;
  float* rk = rq + 64;
  float* sbeta = rk + 64;
  float* sg_ = sbeta + 64;
  float* gcs = sg_ + 64;
  float* eg = gcs + 64;
  float* gl = eg + 64;
  const int tid = otid(), lane = tid & 63, wid = tid >> 6;
  const bfu* PJ = (const bfu*)(P.ws + WS_PROJ);
  const int tok0 = chunk * 64;
  const bool isS = chunk >= 256;
  float v[64];
  gdn_conv_col(P, l, chunk, (tid < 128) ? (head * 128 + tid) : (512 + head * 128 + (tid - 128)), v);
  {
    bfu* dstb = (tid < 128) ? (qn_b + tid) : (kn_b + (tid - 128));
#pragma unroll
    for (int t = 0; t < 64; ++t) dstb[t * 136] = f2bf(v[t]);
  }
  if (tid < 64) {
    const float* AB = (const float*)(P.ws + WS_AB) + (size_t)(tok0 + tid) * 8;
    sbeta[tid] = sigm(AB[4 + head]);
    sg_[tid] = -__expf(P.in[33][l * 4 + head]) * softplusf(AB[head] + P.in[34][l * 4 + head]);
  }
  __syncthreads();
  if (tid < 128) {
    const bfu* rowp = (tid < 64 ? qn_b : kn_b) + (tid & 63) * 136;
    float s = 0.f;
    for (int d = 0; d < 128; ++d) { const float x = bf2f(rowp[d]); s += x * x; }
    if (tid < 64) rq[tid] = rsqrtf(s + 1e-6f) * 0.08838834764831845f;
    else rk[tid - 64] = rsqrtf(s + 1e-6f);
  } else if (tid < 136) {
    const int sg = tid - 128;
    if (isS) {
      float a = 0.f;
      for (int tt = 0; tt < 8; ++tt) { a += sg_[sg * 8 + tt]; gcs[sg * 8 + tt] = a; eg[sg * 8 + tt] = __expf(a); }
      gl[sg] = a;
    } else if (sg == 0) {
      float a = 0.f;
      for (int t = 0; t < 64; ++t) { a += sg_[t]; gcs[t] = a; eg[t] = __expf(a); }
      for (int s2 = 0; s2 < 8; ++s2) gl[s2] = a;
    }
  }
  __syncthreads();
  if (tid < 128) {
    bfu* QG = (bfu*)(P.ws + WS_GQG) + (size_t)tok0 * 512 + head * 128 + tid;
#pragma unroll
    for (int t = 0; t < 64; ++t) QG[(size_t)t * 512] = f2bf(v[t] * rq[t] * eg[t]);
    gdn_conv_col(P, l, chunk, 1024 + head * 128 + tid, v);
  } else {
    bfu* KD = (bfu*)(P.ws + WS_GKD) + (size_t)(chunk * 4 + head) * 8192 + (size_t)(tid - 128) * 64;
#pragma unroll
    for (int t8 = 0; t8 < 8; ++t8) {
      float kd[8];
#pragma unroll
      for (int e = 0; e < 8; ++e) {
        const int t = t8 * 8 + e;
        kd[e] = v[t] * rk[t] * __expf(gl[isS ? t8 : 0] - gcs[t]);
      }
      uint4 pk;
      pk.x = pk2(kd[0], kd[1]); pk.y = pk2(kd[2], kd[3]); pk.z = pk2(kd[4], kd[5]); pk.w = pk2(kd[6], kd[7]);
      *(uint4*)(KD + t8 * 8) = pk;
    }
  }
  {
    bfu* QK = (bfu*)(P.ws + WS_GQK) + (size_t)(chunk * 4 + head) * 4096;
    const int mt = wid >> 1, nt = wid & 1;
    f32x16 KK, QQ;
#pragma unroll
    for (int r = 0; r < 16; ++r) { KK[r] = 0.f; QQ[r] = 0.f; }
#pragma unroll
    for (int ks = 0; ks < 8; ++ks) {
      const bf16x8 ak = *(const bf16x8*)(kn_b + (mt * 32 + (lane & 31)) * 136 + ks * 16 + (lane >> 5) * 8);
      const bf16x8 aq = *(const bf16x8*)(qn_b + (mt * 32 + (lane & 31)) * 136 + ks * 16 + (lane >> 5) * 8);
      const bf16x8 bk = *(const bf16x8*)(kn_b + (nt * 32 + (lane & 31)) * 136 + ks * 16 + (lane >> 5) * 8);
      KK = MFMA32(ak, bk, KK);
      QQ = MFMA32(aq, bk, QQ);
    }
    const int j = nt * 32 + (lane & 31);
    const float gcj = gcs[j], rkj = rk[j];
#pragma unroll
    for (int r = 0; r < 16; ++r) {
      const int i = mt * 32 + rowmap(r, lane);
      const bool ok = (i >= j) && (!isS || ((i >> 3) == (j >> 3)));
      const float dec = ok ? __expf(gcs[i] - gcj) : 0.f;
      L_s[i * 64 + j] = (i > j) ? sbeta[i] * (rk[i] * rkj * KK[r]) * dec : 0.f;
      QK[i * 64 + j] = f2bf(rq[i] * rkj * QQ[r] * dec);
    }
  }
  __syncthreads();
  {
    if (tid < 128) {
#pragma unroll
      for (int t = 0; t < 64; ++t) v[t] *= sbeta[t];
    } else {
#pragma unroll
      for (int t = 0; t < 64; ++t) v[t] *= rk[t] * sbeta[t] * eg[t];
    }
#pragma unroll
    for (int i = 1; i < 64; ++i) {
      float s = v[i];
#pragma unroll
      for (int j4 = 0; j4 <= (i - 1) / 4; ++j4) {
        const float4 lv = *(const float4*)(L_s + i * 64 + j4 * 4);
        s -= lv.x * v[j4 * 4];
        if (j4 * 4 + 1 < i) s -= lv.y * v[j4 * 4 + 1];
        if (j4 * 4 + 2 < i) s -= lv.z * v[j4 * 4 + 2];
        if (j4 * 4 + 3 < i) s -= lv.w * v[j4 * 4 + 3];
      }
      v[i] = s;
    }
    bfu* dst = (bfu*)(P.ws + (tid < 128 ? WS_GU : WS_GW)) + (size_t)tok0 * 512 + head * 128 + (tid & 127);
#pragma unroll
    for (int t = 0; t < 64; ++t) dst[(size_t)t * 512] = f2bf(v[t]);
  }
  if (tid < 8) ((float*)(P.ws + WS_GDEC))[(chunk * 4 + head) * 32 + tid] = __expf(gl[tid]);
  if (isS) {
    for (int idx = tid; idx < 8 * 3 * 384; idx += 256) {
      const int cq = idx % 384, i = (idx / 384) % 3, sg = idx / 1152;
      const int ch = (cq >> 7) * 512 + head * 128 + (cq & 127);
      const int sseq = (chunk - 256) * 8 + sg;
      P.out[O_SGC + ((size_t)(l * 128 + sseq) * 3 + i) * 1536 + ch] = bf2f(PJ[(size_t)(tok0 + sg * 8 + 5 + i) * NPJ + C_QKV + ch]);
    }
  } else if ((chunk & 31) == 31) {
    for (int idx = tid; idx < 3 * 384; idx += 256) {
      const int cq = idx % 384, i = idx / 384;
      const int ch = (cq >> 7) * 512 + head * 128 + (cq & 127);
      P.out[O_PGC + ((size_t)(l * 8 + (chunk >> 5)) * 3 + i) * 1536 + ch] = bf2f(PJ[(size_t)(tok0 + 61 + i) * NPJ + C_QKV + ch]);
    }
  }
}

DI void gdn2_task(const Params& P, int l, int useq, int head, int dvs, char* smem) {
  bfu* Sb = (bfu*)smem;
  bfu* Vn = Sb + 32 * 136;
  const int tid = otid(), lane = tid & 63, w = tid >> 6;
  const bool isS = useq >= 8;
  const int sseq = useq - 8;
  const int nch = isS ? 1 : 32;
  const int chunk0 = isS ? (256 + (sseq >> 3)) : useq * 32;
  const int vseg = isS ? (sseq & 7) : -1;
  const bfu* GW = (const bfu*)(P.ws + WS_GW);
  const bfu* GQ = (const bfu*)(P.ws + WS_GQG);
  const bfu* GU = (const bfu*)(P.ws + WS_GU);
  bfu* PJO = (bfu*)(P.ws + WS_PROJ);
  const bfu* GKD = (const bfu*)(P.ws + WS_GKD);
  const bfu* GQK = (const bfu*)(P.ws + WS_GQK);
  const float* GDEC = (const float*)(P.ws + WS_GDEC);
  const int dv = dvs * 32 + (lane & 31);
  f32x16 S;
  if (isS) {
    const float* s0 = P.in[7] + ((size_t)((l * 128 + sseq) * 4 + head) * 128) * 128 + dv;
#pragma unroll
    for (int r = 0; r < 16; ++r) S[r] = s0[(size_t)(32 * w + rowmap(r, lane)) * 128];
  } else {
#pragma unroll
    for (int r = 0; r < 16; ++r) S[r] = 0.f;
  }
  const bf16x8 zero8 = {0, 0, 0, 0, 0, 0, 0, 0};
  for (int ci = 0; ci < nch; ++ci) {
    const int chunk = chunk0 + ci, tok0 = chunk * 64;
    const int mt = w & 1;
    const int row = mt * 32 + (lane & 31);
    const bool rvalid = !isS || ((row >> 3) == vseg);
    bf16x8 aA[8], aQ[4], aK[4];
    float uu[16];
    {
      const bfu* Ab = (w < 2 ? GW : GQ) + (size_t)(tok0 + row) * 512 + head * 128 + (lane >> 5) * 8;
#pragma unroll
      for (int ks = 0; ks < 8; ++ks) aA[ks] = rvalid ? *(const bf16x8*)(Ab + ks * 16) : zero8;
      const bfu* Kb = GKD + ((size_t)(chunk * 4 + head) * 128 + 32 * w + (lane & 31)) * 64 + (lane >> 5) * 8;
#pragma unroll
      for (int ks = 0; ks < 4; ++ks) {
        const bool gv = !isS || ((ks * 2 + (lane >> 5)) == vseg);
        aK[ks] = gv ? *(const bf16x8*)(Kb + ks * 16) : zero8;
      }
      if (w >= 2) {
        const bfu* Qb = GQK + ((size_t)(chunk * 4 + head) * 64 + row) * 64 + (lane >> 5) * 8;
#pragma unroll
        for (int ks = 0; ks < 4; ++ks) aQ[ks] = rvalid ? *(const bf16x8*)(Qb + ks * 16) : zero8;
#pragma unroll
        for (int r = 0; r < 16; ++r) uu[r] = 0.f;
      } else {
#pragma unroll
        for (int ks = 0; ks < 4; ++ks) aQ[ks] = zero8;
#pragma unroll
        for (int r = 0; r < 16; ++r) {
          const int t = mt * 32 + rowmap(r, lane);
          const bool tv = !isS || ((t >> 3) == vseg);
          uu[r] = tv ? bf2f(GU[(size_t)(tok0 + t) * 512 + head * 128 + dv]) : 0.f;
        }
      }
    }
    const float gdec = GDEC[(chunk * 4 + head) * 32 + (isS ? vseg : 0)];
    __syncthreads();
#pragma unroll
    for (int g4 = 0; g4 < 4; ++g4) {
      uint2 pk;
      pk.x = pk2(S[4 * g4], S[4 * g4 + 1]); pk.y = pk2(S[4 * g4 + 2], S[4 * g4 + 3]);
      *(uint2*)(Sb + (lane & 31) * 136 + 32 * w + 8 * g4 + 4 * (lane >> 5)) = pk;
    }
    __syncthreads();
    f32x16 acc;
#pragma unroll
    for (int r = 0; r < 16; ++r) acc[r] = 0.f;
#pragma unroll
    for (int ks = 0; ks < 8; ++ks) {
      const bf16x8 b8 = *(const bf16x8*)(Sb + (lane & 31) * 136 + ks * 16 + (lane >> 5) * 8);
      acc = MFMA32(aA[ks], b8, acc);
    }
    if (w < 2) {
#pragma unroll
      for (int g4 = 0; g4 < 4; ++g4) {
        uint2 pk;
        pk.x = pk2(uu[4 * g4] - acc[4 * g4], uu[4 * g4 + 1] - acc[4 * g4 + 1]);
        pk.y = pk2(uu[4 * g4 + 2] - acc[4 * g4 + 2], uu[4 * g4 + 3] - acc[4 * g4 + 3]);
        *(uint2*)(Vn + (lane & 31) * 72 + mt * 32 + 8 * g4 + 4 * (lane >> 5)) = pk;
      }
    }
    __syncthreads();
    if (w >= 2) {
#pragma unroll
      for (int ks = 0; ks < 4; ++ks) {
        const bf16x8 b8 = *(const bf16x8*)(Vn + (lane & 31) * 72 + ks * 16 + (lane >> 5) * 8);
        acc = MFMA32(aQ[ks], b8, acc);
      }
#pragma unroll
      for (int r = 0; r < 16; ++r) {
        const int t = mt * 32 + rowmap(r, lane);
        const bool tv = !isS || ((t >> 3) == vseg);
        if (tv) PJO[(size_t)(tok0 + t) * NPJ + C_QKV + (head * 4 + dvs) * 64 + (lane & 31)] = f2bf(acc[r]);
      }
    }
    {
#pragma unroll
      for (int r = 0; r < 16; ++r) S[r] *= gdec;
#pragma unroll
      for (int ks = 0; ks < 4; ++ks) {
        const bf16x8 b8 = *(const bf16x8*)(Vn + (lane & 31) * 72 + ks * 16 + (lane >> 5) * 8);
        S = MFMA32(aK[ks], b8, S);
      }
    }
  }
  float* so = P.out + (isS ? (O_SGS + ((size_t)((l * 128 + sseq) * 4 + head) * 128) * 128)
                           : (O_PGS + ((size_t)((l * 8 + useq) * 4 + head) * 128) * 128)) + dv;
#pragma unroll
  for (int r = 0; r < 16; ++r) so[(size_t)(32 * w + rowmap(r, lane)) * 128] = S[r];
}

DI void gdn3_pass(const Params& P, int l) {
  const int tid_ = otid(), lane = tid_ & 63, wid = tid_ >> 6;
  const int nw = gridDim.x * 4, gw = blockIdx.x * 4 + wid;
  const bfu* GU = (const bfu*)(P.ws + WS_GU);
  bfu* PJ = (bfu*)(P.ws + WS_PROJ);
  const float* nwt = P.in[35] + l * 128 + (lane & 15) * 8;
  for (int r = gw; r < T_ALL; r += nw) {
    const uint4 ov = *(const uint4*)(PJ + (size_t)r * NPJ + C_QKV + (lane >> 2) * 64 + (lane & 3) * 8);
    const uint4 zv = *(const uint4*)(PJ + (size_t)r * NPJ + C_Z + lane * 8);
    float o[8], z[8];
    const unsigned ow[4] = {ov.x, ov.y, ov.z, ov.w}, zw[4] = {zv.x, zv.y, zv.z, zv.w};
    float ss = 0.f;
#pragma unroll
    for (int e = 0; e < 4; ++e) {
      o[2 * e] = __uint_as_float(ow[e] << 16); o[2 * e + 1] = __uint_as_float(ow[e] & 0xffff0000u);
      z[2 * e] = __uint_as_float(zw[e] << 16); z[2 * e + 1] = __uint_as_float(zw[e] & 0xffff0000u);
      ss += o[2 * e] * o[2 * e] + o[2 * e + 1] * o[2 * e + 1];
    }
    ss += __shfl_xor(ss, 1, 64); ss += __shfl_xor(ss, 2, 64); ss += __shfl_xor(ss, 4, 64); ss += __shfl_xor(ss, 8, 64);
    const float rn = rsqrtf(ss * (1.f / 128.f) + 1e-6f);
    float res[8];
#pragma unroll
    for (int e = 0; e < 8; ++e) res[e] = o[e] * rn * nwt[e] * siluf(z[e]);
    uint4 pk;
    pk.x = pk2(res[0], res[1]); pk.y = pk2(res[2], res[3]); pk.z = pk2(res[4], res[5]); pk.w = pk2(res[6], res[7]);
    *(uint4*)(PJ + (size_t)r * NPJ + C_Z + lane * 8) = pk;
  }
}

DI void phase_mix1a(const Params& P, int l, char* smem) {
  for (int t = blockIdx.x; t < 1088; t += gridDim.x) {
    __syncthreads();
    gdn1_task(P, l, t >> 2, t & 3, smem);
  }
}
DI void phase_mix1b(const Params& P, int l, char* smem) {
  const int NT = 2048 + 8192;
  for (int t = blockIdx.x; t < NT; t += gridDim.x) {
    __syncthreads();
    if (t < 2048) rg_task(P, l, t >> 3, t & 7, 0, smem);
    else { const int r = t - 2048; s5_task(P, l, r >> 5, r & 31, 0, smem); }
  }
}

DI void phase_mix2(const Params& P, int l, char* smem) {
  const int G = gridDim.x;
  for (int t = blockIdx.x; t < 128; t += G) {
    __syncthreads();
    gdn2_task(P, l, t >> 4, (t >> 2) & 3, t & 3, smem);
  }
  unsigned* ctr = (unsigned*)(P.ws + WS_BAR) + XB_WORDS + 64 * (1 + l);
  volatile int* nxt = (volatile int*)(smem + LDS_BYTES - 16);
  const int NR = 2176 + 2176 + 2048;
  for (;;) {
    __syncthreads();
    if (threadIdx.x == 0) *nxt = (int)__hip_atomic_fetch_add(ctr, 1u, __ATOMIC_RELAXED, __HIP_MEMORY_SCOPE_AGENT);
    __syncthreads();
    const int r = *nxt;
    if (r >= NR) break;
    __syncthreads();
    if (r < 2176) {
#pragma unroll 1
      for (int gg = 0; gg < 4; ++gg) { if (gg) __syncthreads(); s5_task(P, l, r >> 3, (r & 7) * 4 + gg, 1, smem); }
    } else if (r < 4352) { const int q = r - 2176; rg_task(P, l, q >> 3, q & 7, 1, smem); }
    else { const int q = r - 4352; gdn2_task(P, l, 8 + (q >> 4), (q >> 2) & 3, q & 3, smem); }
  }
}

__global__ void __launch_bounds__(256, 2) mega_kernel(Params P) {
  extern __shared__ __attribute__((aligned(16))) char smem[];
  cg::grid_group grid = cg::this_grid();
  char* ws = P.ws;
  if (P.out == nullptr) grid.sync();
  GBar gb;
  gbar_init(gb, (unsigned*)(ws + WS_BAR));
  prep_layer(P, 0, smem);
  norm_pass(P, 0, 0, smem);
  gsync(gb);
#pragma unroll 1
  for (int l = 0; l < 2; ++l) {
    gemm_plain((const bfu*)(ws + WS_H), 1024, (const bfu*)(ws + WS_WIN), 1024, 1024, 3584, (bfu*)(ws + WS_PROJ), NPJ, smem);
    gsync(gb);
    phase_mix1b(P, l, smem);
    gsync(gb);
    phase_mix1a(P, l, smem);
    gsync(gb);
    phase_mix2(P, l, smem);
    gsync(gb);
    gemm_glu(P, l, smem);
    gdn3_pass(P, l);
    gsync(gb);
    gemm_merge(P, smem);
    gsync(gb);
    gemm_plain((const bfu*)(ws + WS_MIXED), 1024, (const bfu*)(ws + WS_WOUT), 1024, 1024, 1024, (bfu*)(ws + WS_MO), 1024, smem);
    gsync(gb);
    norm_pass(P, l, 1, smem);
    gsync(gb);
    gemm_ffn1(P, smem);
    gsync(gb);
    gemm_plain((const bfu*)(ws + WS_ACT), 2816, (const bfu*)(ws + WS_WDN), 2816, 2816, 1024, (bfu*)(ws + WS_FO), 1024, smem);
    gsync(gb);
    norm_pass(P, l, 2, smem);
    if (l == 0) prep_layer(P, 1, smem);
    gsync(gb);
  }
}

extern "C" void kernel_launch(void* const* d_in, const int* in_sizes, int n_in, void* d_out, int out_size, void* d_ws, size_t ws_size,
                              hipStream_t stream) {
  static int grid_blocks = 0;
  if (!grid_blocks) {
    int dev = 0, cus = 0, per_cu = 0;
    hipGetDevice(&dev);
    hipDeviceGetAttribute(&cus, hipDeviceAttributeMultiprocessorCount, dev);
    hipFuncSetAttribute((const void*)mega_kernel, hipFuncAttributeMaxDynamicSharedMemorySize, LDS_BYTES);
    hipOccupancyMaxActiveBlocksPerMultiprocessor(&per_cu, mega_kernel, 256, LDS_BYTES);
    if (per_cu > 2) per_cu = 2;
    if (per_cu < 1) per_cu = 1;
    grid_blocks = cus * per_cu;
    grid_blocks &= ~7;
  }
  if (ws_size < WS_END) { fprintf(stderr, "workspace too small: %zu < %zu\n", ws_size, (size_t)WS_END); return; }
  Params p{};
  for (int i = 0; i < 41; ++i) p.in[i] = (const float*)d_in[i];
  p.out = (float*)d_out;
  p.ws = (char*)d_ws;
  hipMemsetAsync((char*)d_ws + WS_BAR, 0, 16384, stream);
  void* args[] = {&p};
  hipError_t e = hipLaunchCooperativeKernel((const void*)mega_kernel, dim3(grid_blocks), dim3(256), args, LDS_BYTES, stream);
  if (e != hipSuccess) fprintf(stderr, "cooperative launch failed: %s (grid %d)\n", hipGetErrorString(e), grid_blocks);
}
```

```cpp
#include <hip/hip_runtime.h>
#include <hip/hip_cooperative_groups.h>
#include <cstdio>
namespace cg = cooperative_groups;

typedef unsigned short bfu;
using bf16x8 = __attribute__((ext_vector_type(8))) short;
using f32x16 = __attribute__((ext_vector_type(16))) float;
using f32x4  = __attribute__((ext_vector_type(4))) float;
using u32x4  = __attribute__((ext_vector_type(4))) unsigned;
#define DI __device__ __forceinline__
#define MFMA32(a, b, c) __builtin_amdgcn_mfma_f32_32x32x16_bf16((a), (b), (c), 0, 0, 0)
#define MFMA16(a, b, c) __builtin_amdgcn_mfma_f32_16x16x32_bf16((a), (b), (c), 0, 0, 0)

constexpr int T_ALL = 17408, TP = 16384, NPJ = 3584;
constexpr int C_RGX = 0, C_RGG = 512, C_S5U = 1024, C_QKV = 1536, C_Z = 3072;
constexpr int LDS_BYTES = 65536;

constexpr size_t O_PRC = 17825792, O_PRH = O_PRC + 24576, O_PSR = O_PRH + 8192, O_PSI = O_PSR + 32768,
                 O_PGC = O_PSI + 32768, O_PGS = O_PGC + 73728, O_SRC = O_PGS + 1048576, O_SRH = O_SRC + 393216,
                 O_SSR = O_SRH + 131072, O_SSI = O_SSR + 524288, O_SGC = O_SSI + 524288, O_SGS = O_SGC + 1179648;

constexpr size_t WS_WIN = 0;
constexpr size_t WS_RGO = WS_WIN + (size_t)6656 * 1024 * 2;
constexpr size_t WS_S5O = WS_RGO + (size_t)1024 * 512 * 2;
constexpr size_t WS_GDO = WS_S5O + (size_t)1024 * 512 * 2;
constexpr size_t WS_GLU = WS_GDO + (size_t)1024 * 512 * 2;
constexpr size_t WS_WOUT = WS_GLU + (size_t)512 * 512 * 2;
constexpr size_t WS_WGU = WS_WOUT + (size_t)1024 * 1024 * 2;
constexpr size_t WS_WDN = WS_WGU + (size_t)5632 * 1024 * 2;
constexpr size_t WS_RGW = WS_WDN + (size_t)1024 * 2816 * 2;
constexpr size_t WS_S5BB = WS_RGW + (size_t)8 * 128 * 64 * 2;
constexpr size_t WS_S5CC = WS_S5BB + (size_t)65536 * 2;
constexpr size_t WS_S5LAM = WS_S5CC + (size_t)65536 * 2;
constexpr size_t WS_H = WS_S5LAM + (size_t)4096 * 4;
constexpr size_t WS_PROJ = WS_H + (size_t)T_ALL * 1024 * 2;
constexpr size_t WS_GQG = WS_PROJ + (size_t)T_ALL * NPJ * 2;
constexpr size_t WS_GU = WS_GQG + (size_t)T_ALL * 512 * 2;
constexpr size_t WS_GW = WS_GU + (size_t)T_ALL * 512 * 2;
constexpr size_t WS_GKD = WS_GW + (size_t)T_ALL * 512 * 2;
constexpr size_t WS_GQK = WS_GKD + (size_t)272 * 4 * 128 * 64 * 2;
constexpr size_t WS_AB = WS_GQK + (size_t)272 * 4 * 64 * 64 * 2;
constexpr size_t WS_RGSUM = WS_AB + (size_t)T_ALL * 8 * 4;
constexpr size_t WS_S5SUM = WS_RGSUM + (size_t)256 * 512 * 2 * 4;
constexpr size_t WS_GDEC = WS_S5SUM + (size_t)256 * 32 * 64 * 2 * 4;
constexpr size_t WS_BAR = WS_GDEC + (size_t)272 * 4 * 32 * 4;
constexpr size_t WS_END = WS_BAR + 16384;
constexpr size_t WS_MIXED = WS_GQG, WS_MO = WS_PROJ, WS_ACT = WS_PROJ, WS_FO = WS_GQG;

struct Params {
  const float* in[41];
  float* out;
  char* ws;
};

DI int otid() { int t = threadIdx.x; asm volatile("" : "+v"(t)); return t; }
DI bfu f2bf(float x) { unsigned u = __float_as_uint(x); u += 0x7fffu + ((u >> 16) & 1u); return (bfu)(u >> 16); }
DI float bf2f(bfu v) { return __uint_as_float(((unsigned)v) << 16); }
DI unsigned pk2(float a, float b) { return (unsigned)f2bf(a) | ((unsigned)f2bf(b) << 16); }
DI float sigm(float x) { return 1.f / (1.f + __expf(-x)); }
DI float siluf(float x) { return x * sigm(x); }
DI float geluf(float x) { float u = 0.7978845608028654f * (x + 0.044715f * x * x * x); float t = __expf(2.f * u); return 0.5f * x * (2.f - 2.f / (t + 1.f)); }
DI float softplusf(float x) { return fmaxf(x, 0.f) + log1pf(__expf(-fabsf(x))); }
DI float wsum(float v) { for (int o = 32; o > 0; o >>= 1) v += __shfl_xor(v, o, 64); return v; }
DI int rowmap(int reg, int lane) { return (reg & 3) + 8 * (reg >> 2) + 4 * (lane >> 5); }

template <int MT>
DI void gemm_tile(const bfu* __restrict__ A, int lda, const bfu* __restrict__ W, int ldw, int K, f32x16 (&acc)[MT][2], char* smem) {
  constexpr int BM = 64 * MT, LS = 72;
  bfu* As = (bfu*)smem;
  bfu* Ws = As + BM * LS;
  const int tid = otid(), lane = tid & 63, wid = tid >> 6, wm = wid >> 1, wn = wid & 1;
  const int lr = tid >> 3, lc = tid & 7;
  u32x4 ra[2 * MT], rw[4];
  const bfu* Ap = A + (size_t)lr * lda + lc * 8;
  const bfu* Wp = W + (size_t)lr * ldw + lc * 8;
#pragma unroll
  for (int i = 0; i < 2 * MT; ++i) ra[i] = *(const u32x4*)(Ap + (size_t)i * 32 * lda);
#pragma unroll
  for (int i = 0; i < 4; ++i) rw[i] = *(const u32x4*)(Wp + (size_t)i * 32 * ldw);
  const int nk = K >> 6;
  const int arow = wm * 32 * MT + (lane & 31), wrow = wn * 64 + (lane & 31), kof = (lane >> 5) * 8;
  for (int kt = 0; kt < nk; ++kt) {
    __syncthreads();
#pragma unroll
    for (int i = 0; i < 2 * MT; ++i) *(u32x4*)(As + (lr + 32 * i) * LS + lc * 8) = ra[i];
#pragma unroll
    for (int i = 0; i < 4; ++i) *(u32x4*)(Ws + (lr + 32 * i) * LS + lc * 8) = rw[i];
    if (kt + 1 < nk) {
      Ap += 64; Wp += 64;
#pragma unroll
      for (int i = 0; i < 2 * MT; ++i) ra[i] = *(const u32x4*)(Ap + (size_t)i * 32 * lda);
#pragma unroll
      for (int i = 0; i < 4; ++i) rw[i] = *(const u32x4*)(Wp + (size_t)i * 32 * ldw);
    }
    __syncthreads();
#pragma unroll
    for (int ks = 0; ks < 4; ++ks) {
      bf16x8 af[MT], wf[2];
#pragma unroll
      for (int mt = 0; mt < MT; ++mt) af[mt] = *(const bf16x8*)(As + (arow + mt * 32) * LS + ks * 16 + kof);
#pragma unroll
      for (int nt = 0; nt < 2; ++nt) wf[nt] = *(const bf16x8*)(Ws + (wrow + nt * 32) * LS + ks * 16 + kof);
      __builtin_amdgcn_s_setprio(1);
#pragma unroll
      for (int mt = 0; mt < MT; ++mt)
#pragma unroll
        for (int nt = 0; nt < 2; ++nt) acc[mt][nt] = MFMA32(wf[nt], af[mt], acc[mt][nt]);
      __builtin_amdgcn_s_setprio(0);
    }
  }
}

template <int MT>
DI void zero_acc(f32x16 (&acc)[MT][2]) {
#pragma unroll
  for (int mt = 0; mt < MT; ++mt)
#pragma unroll
    for (int nt = 0; nt < 2; ++nt)
#pragma unroll
      for (int r = 0; r < 16; ++r) acc[mt][nt][r] = 0.f;
}

#define XB_SIMPLE 0
#define XB_CNT(j) (64 * (1 + (j)))
#define XB_XSUB(j) (64 * (17 + (j)))
#define XB_XGEN(j) (64 * (33 + (j)))
#define XB_TOP (64 * 49)
#define XB_TOPGEN (64 * 50)
#define XB_WORDS (64 * 51)
struct GBar { unsigned* w; unsigned x, nloc, nx, k; };
DI unsigned xb_ld(unsigned* p) { return __hip_atomic_load(p, __ATOMIC_RELAXED, __HIP_MEMORY_SCOPE_AGENT); }
DI unsigned xb_add(unsigned* p, unsigned v) { return __hip_atomic_fetch_add(p, v, __ATOMIC_RELAXED, __HIP_MEMORY_SCOPE_AGENT); }
DI void gbar_init(GBar& b, unsigned* w) {
  b.w = w; b.k = 0; b.nloc = 1; b.nx = 1;
  b.x = (unsigned)__builtin_amdgcn_s_getreg((3 << 11) | 20) & 0xFu;
  if (threadIdx.x == 0) {
    const unsigned r0 = xb_add(&w[XB_CNT(b.x)], 1u);
    asm volatile("s_waitcnt vmcnt(0)" ::"v"(r0) : "memory");
    xb_add(&w[XB_SIMPLE], 1u);
    while (xb_ld(&w[XB_SIMPLE]) < gridDim.x) __builtin_amdgcn_s_sleep(1);
    unsigned mine = 1u, cnt = 0u;
    for (unsigned j = 0; j < 16; ++j) { const unsigned c = xb_ld(&w[XB_CNT(j)]); cnt += (c > 0u) ? 1u : 0u; mine = (j == b.x) ? c : mine; }
    b.nloc = mine; b.nx = cnt;
  }
  __syncthreads();
}
DI void gsync(GBar& b) {
  asm volatile("s_waitcnt vmcnt(0)" ::: "memory");
  __syncthreads();
  if (threadIdx.x == 0) {
    unsigned* w = b.w;
    const unsigned gen = b.k;
    const unsigned old = xb_add(&w[XB_XSUB(b.x)], 1u);
    if (old + 1u == (gen + 1u) * b.nloc) {
      __builtin_amdgcn_fence(__ATOMIC_RELEASE, "agent");
      asm volatile("s_waitcnt vmcnt(0)" ::: "memory");
      const unsigned og = xb_add(&w[XB_TOP], 1u);
      if (og + 1u == (gen + 1u) * b.nx) xb_add(&w[XB_TOPGEN], 1u);
      else while (xb_ld(&w[XB_TOPGEN]) == gen) __builtin_amdgcn_s_sleep(1);
      __builtin_amdgcn_fence(__ATOMIC_ACQUIRE, "agent");
      xb_add(&w[XB_XGEN(b.x)], 1u);
      asm volatile("s_waitcnt vmcnt(0)" ::: "memory");
    } else {
      while (xb_ld(&w[XB_XGEN(b.x)]) == gen) __builtin_amdgcn_s_sleep(1);
      __builtin_amdgcn_fence(__ATOMIC_ACQUIRE, "agent");
      asm volatile("s_waitcnt vmcnt(0)" ::: "memory");
    }
  }
  b.k += 1;
  __syncthreads();
}

DI bool tile_map(int it, int nM, int nN, int& tm, int& tn) {
  const int ntiles = nM * nN, per = (ntiles + 7) >> 3;
  const int xcd = blockIdx.x & 7, local = (blockIdx.x >> 3) + it * (gridDim.x >> 3);
  if (local >= per) return false;
  const int q = xcd * per + local;
  if (q >= ntiles) return false;
  const int grp = q / (8 * nN), fm = grp * 8, gsz = min(nM - fm, 8), within = q - grp * 8 * nN;
  tm = fm + within % gsz; tn = within / gsz;
  return true;
}

DI void tile_of(int q, int nM, int nN, int& tm, int& tn) {
  const int grp = q / (8 * nN), fm = grp * 8, gsz = min(nM - fm, 8), within = q - grp * 8 * nN;
  tm = fm + within % gsz; tn = within / gsz;
}
template <int MT>
DI void plain_tile(const bfu* A, int lda, const bfu* W, int ldw, int K, bfu* C, int ldc, int m0, int n0, char* smem) {
  const int tid_ = otid(), lane = tid_ & 63, wid = tid_ >> 6, wm = wid >> 1, wn = wid & 1;
  f32x16 acc[MT][2];
  zero_acc<MT>(acc);
  gemm_tile<MT>(A + (size_t)m0 * lda, lda, W + (size_t)n0 * ldw, ldw, K, acc, smem);
  __syncthreads();
  {
    char* cs = smem;
#pragma unroll
    for (int mt = 0; mt < MT; ++mt) {
      const int m = wm * 32 * MT + mt * 32 + (lane & 31), sw = m & 31;
#pragma unroll
      for (int nt = 0; nt < 2; ++nt)
#pragma unroll
        for (int g4 = 0; g4 < 4; ++g4) {
          const int c8 = (wn * 64 + nt * 32 + 8 * g4 + 4 * (lane >> 5)) >> 2;
          uint2 pk;
          pk.x = pk2(acc[mt][nt][4 * g4], acc[mt][nt][4 * g4 + 1]);
          pk.y = pk2(acc[mt][nt][4 * g4 + 2], acc[mt][nt][4 * g4 + 3]);
          *(uint2*)(cs + m * 256 + ((c8 ^ sw) << 3)) = pk;
        }
    }
  }
  __syncthreads();
  {
    const char* cs = smem;
    const int jj = tid_ & 15;
#pragma unroll
    for (int i = 0; i < 4 * MT; ++i) {
      const int row = (tid_ >> 4) + 16 * i, sw = row & 31;
      uint4 v = *(const uint4*)(cs + row * 256 + ((jj ^ (sw >> 1)) << 4));
      if (sw & 1) { const unsigned t0 = v.x, t1 = v.y; v.x = v.z; v.y = v.w; v.z = t0; v.w = t1; }
      *(uint4*)(C + (size_t)(m0 + row) * ldc + n0 + jj * 8) = v;
    }
  }
}
DI void gemm_plain(const bfu* A, int lda, const bfu* W, int ldw, int K, int N, bfu* C, int ldc, char* smem) {
  const int nM = T_ALL / 256, nN = N / 128, ntiles = nM * nN, G = gridDim.x;
  const int rem = ntiles % G;
  const bool split = (rem > 0) && (rem * 4 <= G) && ((G & 7) == 0);
  if (!split) {
    for (int it = 0;; ++it) {
      int tm, tn;
      if (!tile_map(it, nM, nN, tm, tn)) break;
      plain_tile<4>(A, lda, W, ldw, K, C, ldc, tm * 256, tn * 128, smem);
    }
    return;
  }
  const int nfull = ntiles - rem, per = nfull >> 3;
  const int xcd = blockIdx.x & 7, slots = G >> 3;
  for (int local = blockIdx.x >> 3; local < per; local += slots) {
    int tm, tn;
    tile_of(xcd * per + local, nM, nN, tm, tn);
    plain_tile<4>(A, lda, W, ldw, K, C, ldc, tm * 256, tn * 128, smem);
  }
  for (int sidx = blockIdx.x; sidx < rem * 4; sidx += G) {
    int tm, tn;
    tile_of(nfull + (sidx >> 2), nM, nN, tm, tn);
    plain_tile<1>(A, lda, W, ldw, K, C, ldc, tm * 256 + (sidx & 3) * 64, tn * 128, smem);
  }
}

DI void gemm_glu(const Params& P, int l, char* smem) {
  bfu* PJ = (bfu*)(P.ws + WS_PROJ);
  const bfu* W = (const bfu*)(P.ws + WS_GLU);
  const float* gb = P.in[30] + l * 512;
  const int nM = T_ALL / 256, nN = 4;
  const int tid_ = otid(), lane = tid_ & 63, wid = tid_ >> 6, wm = wid >> 1, wn = wid & 1;
  for (int it = 0;; ++it) {
    int tm, tn;
    if (!tile_map(it, nM, nN, tm, tn)) break;
    f32x16 acc[4][2];
    zero_acc<4>(acc);
    gemm_tile<4>(PJ + (size_t)tm * 256 * NPJ + C_S5U, NPJ, W + (size_t)tn * 128 * 512, 512, 512, acc, smem);
#pragma unroll
    for (int mt = 0; mt < 4; ++mt) {
      const int m = tm * 256 + wm * 128 + mt * 32 + (lane & 31);
#pragma unroll
      for (int nt = 0; nt < 2; ++nt)
#pragma unroll
        for (int g4 = 0; g4 < 4; ++g4) {
          const int n = tn * 128 + wn * 64 + nt * 32 + 8 * g4 + 4 * (lane >> 5);
          const uint2 yv = *(const uint2*)(PJ + (size_t)m * NPJ + C_S5U + n);
          const float4 bv = *(const float4*)(gb + n);
          const float y0 = bf2f((bfu)(yv.x & 0xffff)), y1 = bf2f((bfu)(yv.x >> 16)), y2 = bf2f((bfu)(yv.y & 0xffff)), y3 = bf2f((bfu)(yv.y >> 16));
          uint2 pk;
          pk.x = pk2(y0 * sigm(acc[mt][nt][4 * g4] + bv.x), y1 * sigm(acc[mt][nt][4 * g4 + 1] + bv.y));
          pk.y = pk2(y2 * sigm(acc[mt][nt][4 * g4 + 2] + bv.z), y3 * sigm(acc[mt][nt][4 * g4 + 3] + bv.w));
          *(uint2*)(PJ + (size_t)m * NPJ + C_RGX + n) = pk;
        }
    }
  }
}

DI void gemm_ffn1(const Params& P, char* smem) {
  const bfu* A = (const bfu*)(P.ws + WS_H);
  const bfu* W = (const bfu*)(P.ws + WS_WGU);
  bfu* C = (bfu*)(P.ws + WS_ACT);
  const int nM = T_ALL / 256, nN = 44;
  const int tid_ = otid(), lane = tid_ & 63, wid = tid_ >> 6, wm = wid >> 1, wn = wid & 1;
  for (int it = 0;; ++it) {
    int tm, tn;
    if (!tile_map(it, nM, nN, tm, tn)) break;
    f32x16 acc[4][2];
    zero_acc<4>(acc);
    gemm_tile<4>(A + (size_t)tm * 256 * 1024, 1024, W + (size_t)tn * 128 * 1024, 1024, 1024, acc, smem);
#pragma unroll
    for (int mt = 0; mt < 4; ++mt) {
      const int m = tm * 256 + wm * 128 + mt * 32 + (lane & 31);
#pragma unroll
      for (int g4 = 0; g4 < 4; ++g4) {
        const int j = tn * 64 + wn * 32 + 8 * g4 + 4 * (lane >> 5);
        uint2 pk;
        pk.x = pk2(siluf(acc[mt][0][4 * g4]) * acc[mt][1][4 * g4], siluf(acc[mt][0][4 * g4 + 1]) * acc[mt][1][4 * g4 + 1]);
        pk.y = pk2(siluf(acc[mt][0][4 * g4 + 2]) * acc[mt][1][4 * g4 + 2], siluf(acc[mt][0][4 * g4 + 3]) * acc[mt][1][4 * g4 + 3]);
        *(uint2*)(C + (size_t)m * 2816 + j) = pk;
      }
    }
  }
}

template <int MT>
DI void merge_tile(const Params& P, int m0, int tn, char* smem) {
  const bfu* H = (const bfu*)(P.ws + WS_H);
  const bfu* PJ = (const bfu*)(P.ws + WS_PROJ);
  const bfu* WIN = (const bfu*)(P.ws + WS_WIN);
  bfu* C = (bfu*)(P.ws + WS_MIXED);
  const int tid_ = otid(), lane = tid_ & 63, wid = tid_ >> 6, wm = wid >> 1, wn = wid & 1;
  f32x16 tot[MT][2];
  zero_acc<MT>(tot);
#pragma unroll 1
  for (int b = 0; b < 3; ++b) {
    unsigned* gps = (unsigned*)(smem + 36864) + tid_;
    unsigned gkeep[4] = {0u, 0u, 0u, 0u};
    {
      f32x16 g[MT][2];
      zero_acc<MT>(g);
      gemm_tile<MT>(H + (size_t)m0 * 1024, 1024, WIN + (size_t)(3584 + b * 1024 + tn * 128) * 1024, 1024, 1024, g, smem);
#pragma unroll
      for (int mt = 0; mt < MT; ++mt)
#pragma unroll
        for (int nt = 0; nt < 2; ++nt)
#pragma unroll
          for (int r = 0; r < 8; ++r) {
            const unsigned pv = pk2(sigm(g[mt][nt][2 * r]), sigm(g[mt][nt][2 * r + 1]));
            if ((mt * 2 + nt) * 8 + r < 28) gps[((mt * 2 + nt) * 8 + r) * 256] = pv;
            else gkeep[((mt * 2 + nt) * 8 + r) - 28] = pv;
          }
    }
    const int colb = (b == 0) ? C_RGG : (b == 1 ? C_RGX : C_Z);
    const bfu* Wo = (const bfu*)(P.ws + (b == 0 ? WS_RGO : (b == 1 ? WS_S5O : WS_GDO)));
    f32x16 y[MT][2];
    zero_acc<MT>(y);
    gemm_tile<MT>(PJ + (size_t)m0 * NPJ + colb, NPJ, Wo + (size_t)tn * 128 * 512, 512, 512, y, smem);
#pragma unroll
    for (int mt = 0; mt < MT; ++mt)
#pragma unroll
      for (int nt = 0; nt < 2; ++nt)
#pragma unroll
        for (int r = 0; r < 8; ++r) {
          const unsigned gv = ((mt * 2 + nt) * 8 + r < 28) ? gps[((mt * 2 + nt) * 8 + r) * 256] : gkeep[((mt * 2 + nt) * 8 + r) - 28];
          tot[mt][nt][2 * r] += __uint_as_float(gv << 16) * y[mt][nt][2 * r];
          tot[mt][nt][2 * r + 1] += __uint_as_float(gv & 0xffff0000u) * y[mt][nt][2 * r + 1];
        }
  }
#pragma unroll
  for (int mt = 0; mt < MT; ++mt) {
    const int m = m0 + wm * 32 * MT + mt * 32 + (lane & 31);
#pragma unroll
    for (int nt = 0; nt < 2; ++nt)
#pragma unroll
      for (int g4 = 0; g4 < 4; ++g4) {
        const int n = tn * 128 + wn * 64 + nt * 32 + 8 * g4 + 4 * (lane >> 5);
        uint2 pk;
        pk.x = pk2(tot[mt][nt][4 * g4], tot[mt][nt][4 * g4 + 1]);
        pk.y = pk2(tot[mt][nt][4 * g4 + 2], tot[mt][nt][4 * g4 + 3]);
        *(uint2*)(C + (size_t)m * 1024 + n) = pk;
      }
  }
}
DI void gemm_merge(const Params& P, char* smem) {
  const int nM = T_ALL / 128, nN = 8, ntiles = nM * nN, G = gridDim.x;
  const int rem = ntiles % G;
  const bool split = (rem > 0) && (rem * 2 <= G / 2) && ((G & 7) == 0);
  if (!split) {
    for (int it = 0;; ++it) {
      int tm, tn;
      if (!tile_map(it, nM, nN, tm, tn)) break;
      merge_tile<2>(P, tm * 128, tn, smem);
    }
    return;
  }
  const int nfull = ntiles - rem, per = nfull >> 3;
  const int xcd = blockIdx.x & 7, slots = G >> 3;
  for (int local = blockIdx.x >> 3; local < per; local += slots) {
    int tm, tn;
    tile_of(xcd * per + local, nM, nN, tm, tn);
    merge_tile<2>(P, tm * 128, tn, smem);
  }
  for (int sidx = blockIdx.x; sidx < rem * 2; sidx += G) {
    int tm, tn;
    tile_of(nfull + (sidx >> 1), nM, nN, tm, tn);
    merge_tile<1>(P, tm * 128 + (sidx & 1) * 64, tn, smem);
  }
}

DI void cvt_job(const float* src, int ld, int K, int ncols, bfu* dst, int ldd, int mode, float* sm) {
  const int nkt = K >> 6, nnt = ncols >> 6, nt = nkt * nnt;
  const int tid = otid();
  for (int t = blockIdx.x; t < nt; t += gridDim.x) {
    const int kt = t % nkt, ct = t / nkt;
    const int k0 = kt * 64, c0 = ct * 64;
    float4 v[4];
#pragma unroll
    for (int i = 0; i < 4; ++i) v[i] = *(const float4*)(src + (size_t)(k0 + (tid >> 4) + 16 * i) * ld + c0 + (tid & 15) * 4);
    __syncthreads();
#pragma unroll
    for (int i = 0; i < 4; ++i) {
      const int k = (tid >> 4) + 16 * i, n = (tid & 15) * 4;
      sm[(n + 0) * 65 + k] = v[i].x; sm[(n + 1) * 65 + k] = v[i].y; sm[(n + 2) * 65 + k] = v[i].z; sm[(n + 3) * 65 + k] = v[i].w;
    }
    __syncthreads();
    const int n = tid >> 2, ks = (tid & 3) * 16;
    const int row = (mode == 0) ? (c0 + n) : (ct * 128 + (n >> 5) * 64 + (mode - 1) * 32 + (n & 31));
    uint4 w0, w1;
    const float* r = sm + n * 65 + ks;
    w0.x = pk2(r[0], r[1]); w0.y = pk2(r[2], r[3]); w0.z = pk2(r[4], r[5]); w0.w = pk2(r[6], r[7]);
    w1.x = pk2(r[8], r[9]); w1.y = pk2(r[10], r[11]); w1.z = pk2(r[12], r[13]); w1.w = pk2(r[14], r[15]);
    *(uint4*)(dst + (size_t)row * ldd + k0 + ks) = w0;
    *(uint4*)(dst + (size_t)row * ldd + k0 + ks + 8) = w1;
  }
}

DI void prep_layer(const Params& P, int l, char* smem) {
  float* sm = (float*)smem;
  char* ws = P.ws;
  cvt_job(P.in[12] + (size_t)l * 1024 * 6664, 6664, 1024, 3584, (bfu*)(ws + WS_WIN), 1024, 0, sm);
  cvt_job(P.in[12] + (size_t)l * 1024 * 6664 + 3592, 6664, 1024, 3072, (bfu*)(ws + WS_WIN) + (size_t)3584 * 1024, 1024, 0, sm);
  cvt_job(P.in[20] + (size_t)l * 512 * 1024, 1024, 512, 1024, (bfu*)(ws + WS_RGO), 512, 0, sm);
  cvt_job(P.in[31] + (size_t)l * 512 * 1024, 1024, 512, 1024, (bfu*)(ws + WS_S5O), 512, 0, sm);
  cvt_job(P.in[36] + (size_t)l * 512 * 1024, 1024, 512, 1024, (bfu*)(ws + WS_GDO), 512, 0, sm);
  cvt_job(P.in[29] + (size_t)l * 512 * 512, 512, 512, 512, (bfu*)(ws + WS_GLU), 512, 0, sm);
  cvt_job(P.in[37] + (size_t)l * 1024 * 1024, 1024, 1024, 1024, (bfu*)(ws + WS_WOUT), 1024, 0, sm);
  cvt_job(P.in[38] + (size_t)l * 1024 * 2816, 2816, 1024, 2816, (bfu*)(ws + WS_WGU), 1024, 1, sm);
  cvt_job(P.in[39] + (size_t)l * 1024 * 2816, 2816, 1024, 2816, (bfu*)(ws + WS_WGU), 1024, 2, sm);
  cvt_job(P.in[40] + (size_t)l * 2816 * 1024, 1024, 2816, 1024, (bfu*)(ws + WS_WDN), 2816, 0, sm);
#pragma unroll 1
  for (int n = 0; n < 8; ++n) {
    cvt_job(P.in[15] + (size_t)(l * 8 + n) * 4096, 64, 64, 64, (bfu*)(ws + WS_RGW) + (size_t)n * 8192, 64, 0, sm);
    cvt_job(P.in[17] + (size_t)(l * 8 + n) * 4096, 64, 64, 64, (bfu*)(ws + WS_RGW) + (size_t)n * 8192 + 4096, 64, 0, sm);
  }
  bfu* BB = (bfu*)(ws + WS_S5BB);
  bfu* CC = (bfu*)(ws + WS_S5CC);
  float* LAM = (float*)(ws + WS_S5LAM);
  for (int idx = blockIdx.x * 256 + otid(); idx < 2048; idx += gridDim.x * 256) {
    const int g = idx >> 6, p = idx & 63;
    const float ar = P.in[21][l * 2048 + idx], ai = P.in[22][l * 2048 + idx];
    const float dt = expf(P.in[28][l * 32 + g]);
    const float mag = expf(ar * dt), ang = ai * dt;
    const float lr = mag * cosf(ang), li = mag * sinf(ang);
    LAM[idx * 2] = lr; LAM[idx * 2 + 1] = li;
    const float den = 1.f / (ar * ar + ai * ai);
    const float cr = ((lr - 1.f) * ar + li * ai) * den, ci = (li * ar - (lr - 1.f) * ai) * den;
    const float* bre = P.in[23] + ((size_t)(l * 32 + g) * 64 + p) * 16;
    const float* bim = P.in[24] + ((size_t)(l * 32 + g) * 64 + p) * 16;
    for (int h = 0; h < 16; ++h) {
      const float br = bre[h], bi = bim[h];
      BB[(size_t)(g * 128 + p) * 16 + h] = f2bf(cr * br - ci * bi);
      BB[(size_t)(g * 128 + 64 + p) * 16 + h] = f2bf(cr * bi + ci * br);
      CC[(size_t)(g * 16 + h) * 128 + p] = f2bf(P.in[25][((size_t)(l * 32 + g) * 16 + h) * 64 + p]);
      CC[(size_t)(g * 16 + h) * 128 + 64 + p] = f2bf(-P.in[26][((size_t)(l * 32 + g) * 16 + h) * 64 + p]);
    }
  }
}

DI void norm_pass(const Params& P, int l, int mode, char* smem) {
  const int tid_ = otid(), lane = tid_ & 63, wid = tid_ >> 6;
  const int nw = gridDim.x * 4, gw = blockIdx.x * 4 + wid;
  const bfu* src = (const bfu*)(P.ws + (mode == 1 ? WS_MO : WS_FO));
  const float* gA = (mode == 1 ? P.in[9] : P.in[11]) + l * 1024;
  const bool doH = (mode != 2) || (l == 0);
  const float* gB = (mode == 0) ? P.in[8] : (mode == 1 ? P.in[10] + l * 1024 : P.in[8] + 1024);
  const bool doAB = (mode == 0) || (mode == 2 && l == 0);
  const int lab = (mode == 0) ? 0 : 1;
  const float* W8 = P.in[12] + (size_t)lab * 1024 * 6664 + 3584;
  bfu* H = (bfu*)(P.ws + WS_H);
  float* AB = (float*)(P.ws + WS_AB);
  float* W8s = (float*)smem;
  if (doAB) {
    __syncthreads();
    for (int idx = tid_; idx < 8192; idx += 256) W8s[(idx & 7) * 1024 + (idx >> 3)] = W8[(size_t)(idx >> 3) * 6664 + (idx & 7)];
    __syncthreads();
  }
  for (int r = gw; r < T_ALL; r += nw) {
    float4 xv[4];
    float* xo = P.out + (size_t)r * 1024;
    if (mode == 0) {
      const float* xi = (r < TP) ? (P.in[0] + (size_t)r * 1024) : (P.in[1] + (size_t)(r - TP) * 1024);
#pragma unroll
      for (int i = 0; i < 4; ++i) xv[i] = *(const float4*)(xi + lane * 4 + 256 * i);
    } else {
      float4 av[4];
      float ss = 0.f;
#pragma unroll
      for (int i = 0; i < 4; ++i) {
        xv[i] = *(const float4*)(xo + lane * 4 + 256 * i);
        const uint2 s2 = *(const uint2*)(src + (size_t)r * 1024 + lane * 4 + 256 * i);
        av[i].x = bf2f((bfu)(s2.x & 0xffff)); av[i].y = bf2f((bfu)(s2.x >> 16));
        av[i].z = bf2f((bfu)(s2.y & 0xffff)); av[i].w = bf2f((bfu)(s2.y >> 16));
        ss += av[i].x * av[i].x + av[i].y * av[i].y + av[i].z * av[i].z + av[i].w * av[i].w;
      }
      ss = wsum(ss);
      const float sa = rsqrtf(ss * (1.f / 1024.f) + 1e-6f);
#pragma unroll
      for (int i = 0; i < 4; ++i) {
        const float4 gv = *(const float4*)(gA + lane * 4 + 256 * i);
        xv[i].x += av[i].x * sa * gv.x; xv[i].y += av[i].y * sa * gv.y;
        xv[i].z += av[i].z * sa * gv.z; xv[i].w += av[i].w * sa * gv.w;
      }
    }
#pragma unroll
    for (int i = 0; i < 4; ++i) *(float4*)(xo + lane * 4 + 256 * i) = xv[i];
    if (doH) {
      float ss = 0.f;
#pragma unroll
      for (int i = 0; i < 4; ++i) ss += xv[i].x * xv[i].x + xv[i].y * xv[i].y + xv[i].z * xv[i].z + xv[i].w * xv[i].w;
      ss = wsum(ss);
      const float sc = rsqrtf(ss * (1.f / 1024.f) + 1e-6f);
      float ab[8];
#pragma unroll
      for (int j = 0; j < 8; ++j) ab[j] = 0.f;
#pragma unroll
      for (int i = 0; i < 4; ++i) {
        const float4 gv = *(const float4*)(gB + lane * 4 + 256 * i);
        float hv[4] = {xv[i].x * sc * gv.x, xv[i].y * sc * gv.y, xv[i].z * sc * gv.z, xv[i].w * sc * gv.w};
        uint2 pk;
        pk.x = pk2(hv[0], hv[1]); pk.y = pk2(hv[2], hv[3]);
        *(uint2*)(H + (size_t)r * 1024 + lane * 4 + 256 * i) = pk;
        if (doAB) {
#pragma unroll
          for (int j = 0; j < 8; ++j) {
            const float4 wj = *(const float4*)(W8s + j * 1024 + lane * 4 + 256 * i);
            ab[j] += hv[0] * wj.x; ab[j] += hv[1] * wj.y; ab[j] += hv[2] * wj.z; ab[j] += hv[3] * wj.w;
          }
        }
      }
      if (doAB) {
#pragma unroll
        for (int j = 0; j < 8; ++j) ab[j] = wsum(ab[j]);
        if (lane == 0) {
          *(float4*)(AB + (size_t)r * 8) = make_float4(ab[0], ab[1], ab[2], ab[3]);
          *(float4*)(AB + (size_t)r * 8 + 4) = make_float4(ab[4], ab[5], ab[6], ab[7]);
        }
      }
    }
  }
}

DI void rg_task(const Params& P, int l, int chunk, int n, int mode, char* smem) {
  float* xc_f = (float*)smem;
  bfu* xc_b = (bfu*)(xc_f + 64 * 65);
  float* a_s = (float*)(xc_b + 64 * 72);
  float* in_s = a_s + 4096;
  float* segP = in_s + 4096;
  float* segH = segP + 512;
  float* car = segH + 512;
  float* part = car + 64;
  const int tid = otid(), lane = tid & 63, wid = tid >> 6;
  bfu* PJ = (bfu*)(P.ws + WS_PROJ);
  const int tok0 = chunk * 64;
  const bool isS = chunk >= 256;
  const int c = tid & 63, tq = tid >> 6, cc = n * 64 + c;
  const bfu* RGW = (const bfu*)(P.ws + WS_RGW) + (size_t)n * 8192;
  bf16x8 wbr[4], wbi[4];
#pragma unroll
  for (int ks = 0; ks < 4; ++ks) {
    wbr[ks] = *(const bf16x8*)(RGW + ((wid & 1) * 32 + (lane & 31)) * 64 + ks * 16 + (lane >> 5) * 8);
    wbi[ks] = *(const bf16x8*)(RGW + (64 + (wid & 1) * 32 + (lane & 31)) * 64 + ks * 16 + (lane >> 5) * 8);
  }
  const int cch0 = n * 64 + (wid & 1) * 32 + (lane & 31);
  const float ba = P.in[16][l * 512 + cch0], bx = P.in[18][l * 512 + cch0];
  const float sp = softplusf(-P.in[19][l * 512 + cch0]);
  float gt2[2][8];
  float2 rprev[8];
  float* RGSUM = (float*)(P.ws + WS_RGSUM);
  if (mode != 0) {
#pragma unroll
    for (int q = 0; q < 2; ++q)
#pragma unroll
      for (int tt = 0; tt < 8; ++tt) gt2[q][tt] = bf2f(PJ[(size_t)(tok0 + (tq + 4 * q) * 8 + tt) * NPJ + C_RGG + cc]);
    if (!isS) {
      const int ci = chunk & 31, cs = chunk & ~31;
#pragma unroll
      for (int i = 0; i < 8; ++i) {
        const int c2 = tq * 8 + i;
        rprev[i] = (c2 < ci) ? *(const float2*)(RGSUM + ((size_t)(cs + c2) * 512 + cc) * 2) : make_float2(1.f, 0.f);
      }
    }
  }
  {
    const float* cw = P.in[13] + l * 2048;
    const float w0 = cw[cc], w1 = cw[512 + cc], w2 = cw[1024 + cc], w3 = cw[1536 + cc], cb = P.in[14][l * 512 + cc];
    if (!isS) {
      bfu* xs = (bfu*)a_s;
      const bool first = (chunk & 31) == 0;
#pragma unroll
      for (int j = 0; j < 3; ++j) {
        const int idx = tid + 256 * j;
        if (idx < 67 * 8) {
          const int row = idx >> 3, ch = idx & 7;
          u32x4 v = {0u, 0u, 0u, 0u};
          if (!(first && row < 3)) v = *(const u32x4*)(PJ + (size_t)(tok0 - 3 + row) * NPJ + C_RGX + n * 64 + ch * 8);
          *(u32x4*)(xs + row * 64 + ch * 8) = v;
        }
      }
      __syncthreads();
#pragma unroll 4
      for (int i = 0; i < 16; ++i) {
        const int t = tq + 4 * i;
        const float acc = cb + w0 * bf2f(xs[t * 64 + c]) + w1 * bf2f(xs[(t + 1) * 64 + c]) + w2 * bf2f(xs[(t + 2) * 64 + c]) + w3 * bf2f(xs[(t + 3) * 64 + c]);
        xc_f[t * 65 + c] = acc;
        xc_b[t * 72 + c] = f2bf(acc);
      }
    } else {
#pragma unroll 4
      for (int i = 0; i < 16; ++i) {
        const int t = tq + 4 * i, tok = tok0 + t, tl = tok & 7;
        float xk[4];
#pragma unroll
        for (int k = 0; k < 4; ++k) {
          const int j = tl + k - 3;
          if (j >= 0) xk[k] = bf2f(PJ[(size_t)(tok + k - 3) * NPJ + C_RGX + cc]);
          else xk[k] = P.in[2][((size_t)(l * 128 + ((tok - TP) >> 3)) * 3 + (tl + k)) * 512 + cc];
        }
        const float acc = cb + w0 * xk[0] + w1 * xk[1] + w2 * xk[2] + w3 * xk[3];
        xc_f[t * 65 + c] = acc;
        xc_b[t * 72 + c] = f2bf(acc);
      }
    }
  }
  __syncthreads();
  {
    const int mt = wid >> 1, ntl = wid & 1;
    f32x16 R, I;
#pragma unroll
    for (int r = 0; r < 16; ++r) { R[r] = 0.f; I[r] = 0.f; }
#pragma unroll
    for (int ks = 0; ks < 4; ++ks) {
      const bf16x8 a = *(const bf16x8*)(xc_b + (mt * 32 + (lane & 31)) * 72 + ks * 16 + (lane >> 5) * 8);
      R = MFMA32(a, wbr[ks], R);
      I = MFMA32(a, wbi[ks], I);
    }
    const int ch = ntl * 32 + (lane & 31);
#pragma unroll
    for (int r = 0; r < 16; ++r) {
      const int t = mt * 32 + rowmap(r, lane);
      const float rr = sigm(R[r] + ba), ig = sigm(I[r] + bx);
      const float la = -8.f * rr * sp;
      const float a = __expf(la);
      const float inp = sqrtf(fmaxf(-expm1f(2.f * la), 0.f)) * ig * xc_f[t * 65 + ch];
      a_s[t * 64 + ch] = a;
      in_s[t * 64 + ch] = inp;
    }
  }
  __syncthreads();
#pragma unroll
  for (int q = 0; q < 2; ++q) {
    const int sg = tq + 4 * q;
    float Pp = 1.f, Hh = 0.f;
#pragma unroll
    for (int tt = 0; tt < 8; ++tt) {
      const float a = a_s[(sg * 8 + tt) * 64 + c];
      Hh = a * Hh + in_s[(sg * 8 + tt) * 64 + c];
      Pp *= a;
    }
    segP[sg * 64 + c] = Pp; segH[sg * 64 + c] = Hh;
  }
  __syncthreads();
  if (mode == 0) {
    if (tid < 64) {
      float Pp = 1.f, Hh = 0.f;
#pragma unroll
      for (int sg = 0; sg < 8; ++sg) { Hh = segP[sg * 64 + c] * Hh + segH[sg * 64 + c]; Pp *= segP[sg * 64 + c]; }
      *(float2*)(RGSUM + ((size_t)chunk * 512 + cc) * 2) = make_float2(Pp, Hh);
    }
    return;
  }
  if (!isS) {
    const int ci = chunk & 31, cs = chunk & ~31;
    float Pp = 1.f, Hh = 0.f;
#pragma unroll
    for (int i = 0; i < 8; ++i) {
      const int c2 = tq * 8 + i;
      if (c2 < ci) {
        const float2 ph = rprev[i];
        Hh = ph.x * Hh + ph.y; Pp *= ph.x;
      }
    }
    part[(tq * 64 + c) * 2] = Pp; part[(tq * 64 + c) * 2 + 1] = Hh;
    __syncthreads();
    if (tid < 64) {
      float h = 0.f;
#pragma unroll
      for (int q2 = 0; q2 < 4; ++q2) h = part[(q2 * 64 + c) * 2] * h + part[(q2 * 64 + c) * 2 + 1];
      car[c] = h;
    }
    __syncthreads();
  }
#pragma unroll
  for (int q = 0; q < 2; ++q) {
    const int sg = tq + 4 * q;
    float h;
    const int sseq = (tok0 - TP) / 8 + sg;
    if (isS) h = P.in[3][(size_t)(l * 128 + sseq) * 512 + cc];
    else {
      h = car[c];
      for (int s2 = 0; s2 < sg; ++s2) h = segP[s2 * 64 + c] * h + segH[s2 * 64 + c];
    }
#pragma unroll
    for (int tt = 0; tt < 8; ++tt) {
      const int t = sg * 8 + tt;
      h = a_s[t * 64 + c] * h + in_s[t * 64 + c];
      PJ[(size_t)(tok0 + t) * NPJ + C_RGG + cc] = f2bf(h * geluf(gt2[q][tt]));
    }
    if (isS) P.out[O_SRH + (size_t)(l * 128 + sseq) * 512 + cc] = h;
    else if ((chunk & 31) == 31 && sg == 7) P.out[O_PRH + (size_t)(l * 8 + (chunk >> 5)) * 512 + cc] = h;
  }
  if (isS) {
    for (int idx = tid; idx < 8 * 3 * 64; idx += 256) {
      const int c3 = idx & 63, i = (idx >> 6) % 3, sg = idx / 192;
      const int sseq = (tok0 - TP) / 8 + sg;
      P.out[O_SRC + ((size_t)(l * 128 + sseq) * 3 + i) * 512 + n * 64 + c3] = bf2f(PJ[(size_t)(tok0 + sg * 8 + 5 + i) * NPJ + C_RGX + n * 64 + c3]);
    }
  } else if ((chunk & 31) == 31) {
    if (tid < 192) {
      const int c3 = tid & 63, i = tid >> 6;
      P.out[O_PRC + ((size_t)(l * 8 + (chunk >> 5)) * 3 + i) * 512 + n * 64 + c3] = bf2f(PJ[(size_t)(tok0 + 61 + i) * NPJ + C_RGX + n * 64 + c3]);
    }
  }
}

DI void s5_task(const Params& P, int l, int chunk, int g, int mode, char* smem) {
  float* bu_s = (float*)smem;
  bfu* ss_b = (bfu*)(bu_s + 8192);
  float* segS = (float*)(ss_b + 64 * 136);
  float* car = segS + 1024;
  float* part = car + 128;
  const int tid = otid(), lane = tid & 63, wid = tid >> 6;
  bfu* PJ = (bfu*)(P.ws + WS_PROJ);
  const int tok0 = chunk * 64;
  const bool isS = chunk >= 256;
  const int p = tid & 63, tq = tid >> 6;
  const float* LAMT = (const float*)(P.ws + WS_S5LAM);
  const float lr = LAMT[(g * 64 + p) * 2], li = LAMT[(g * 64 + p) * 2 + 1];
  float* S5SUM = (float*)(P.ws + WS_S5SUM);
  bf16x8 cfr[4];
  float2 sprev[8];
  float uu[4], st0[4];
  const int hh = lane & 15;
  const float dco = P.in[27][l * 512 + g * 16 + hh];
  if (mode != 0) {
    const bfu* CC = (const bfu*)(P.ws + WS_S5CC) + (size_t)g * 2048;
#pragma unroll
    for (int ks = 0; ks < 4; ++ks) cfr[ks] = *(const bf16x8*)(CC + (lane & 15) * 128 + ks * 32 + (lane >> 4) * 8);
#pragma unroll
    for (int r = 0; r < 4; ++r) uu[r] = bf2f(PJ[(size_t)(tok0 + wid * 16 + (lane >> 4) * 4 + r) * NPJ + C_S5U + g * 16 + hh]);
    if (!isS) {
      const int ci = chunk & 31, cs = chunk & ~31;
#pragma unroll
      for (int i = 0; i < 8; ++i) {
        const int c2 = tq * 8 + i;
        sprev[i] = (c2 < ci) ? *(const float2*)(S5SUM + (((size_t)(cs + c2) * 32 + g) * 64 + p) * 2) : make_float2(0.f, 0.f);
      }
    } else {
#pragma unroll
      for (int q = 0; q < 2; ++q) {
        const size_t si0 = ((size_t)(l * 128 + (tok0 - TP) / 8 + tq + 4 * q) * 32 + g) * 64 + p;
        st0[2 * q] = P.in[4][si0]; st0[2 * q + 1] = P.in[5][si0];
      }
    }
  }
  {
    const bfu* BB = (const bfu*)(P.ws + WS_S5BB) + (size_t)g * 2048;
    const bf16x8 b = *(const bf16x8*)(BB + (wid * 32 + (lane & 31)) * 16 + (lane >> 5) * 8);
#pragma unroll
    for (int mt = 0; mt < 2; ++mt) {
      const bf16x8 a = *(const bf16x8*)(PJ + (size_t)(tok0 + mt * 32 + (lane & 31)) * NPJ + C_S5U + g * 16 + (lane >> 5) * 8);
      f32x16 d;
#pragma unroll
      for (int r = 0; r < 16; ++r) d[r] = 0.f;
      d = MFMA32(a, b, d);
#pragma unroll
      for (int r = 0; r < 16; ++r) bu_s[(mt * 32 + rowmap(r, lane)) * 128 + wid * 32 + (lane & 31)] = d[r];
    }
  }
  __syncthreads();
#pragma unroll
  for (int q = 0; q < 2; ++q) {
    const int sg = tq + 4 * q;
    float sr = 0.f, si = 0.f;
#pragma unroll
    for (int tt = 0; tt < 8; ++tt) {
      const int t = sg * 8 + tt;
      const float nr = lr * sr - li * si + bu_s[t * 128 + p];
      const float ni = lr * si + li * sr + bu_s[t * 128 + 64 + p];
      sr = nr; si = ni;
    }
    segS[(sg * 64 + p) * 2] = sr; segS[(sg * 64 + p) * 2 + 1] = si;
  }
  __syncthreads();
  float l8r = lr, l8i = li;
#pragma unroll
  for (int k = 0; k < 3; ++k) { const float nr = l8r * l8r - l8i * l8i, ni = 2.f * l8r * l8i; l8r = nr; l8i = ni; }
  if (mode == 0) {
    if (tid < 64) {
      float sr = 0.f, si = 0.f;
#pragma unroll
      for (int sg = 0; sg < 8; ++sg) {
        const float nr = l8r * sr - l8i * si + segS[(sg * 64 + p) * 2];
        const float ni = l8r * si + l8i * sr + segS[(sg * 64 + p) * 2 + 1];
        sr = nr; si = ni;
      }
      *(float2*)(S5SUM + (((size_t)chunk * 32 + g) * 64 + p) * 2) = make_float2(sr, si);
    }
    return;
  }
  if (!isS) {
    float l64r = l8r, l64i = l8i;
#pragma unroll
    for (int k = 0; k < 3; ++k) { const float nr = l64r * l64r - l64i * l64i, ni = 2.f * l64r * l64i; l64r = nr; l64i = ni; }
    const int ci = chunk & 31, cs = chunk & ~31;
    float ar = 0.f, ai = 0.f;
#pragma unroll
    for (int i = 0; i < 8; ++i) {
      const int c2 = tq * 8 + i;
      if (c2 < ci) {
        const float2 sv = sprev[i];
        const float nr = l64r * ar - l64i * ai + sv.x, ni = l64r * ai + l64i * ar + sv.y;
        ar = nr; ai = ni;
      }
    }
    part[(tq * 64 + p) * 2] = ar; part[(tq * 64 + p) * 2 + 1] = ai;
    __syncthreads();
    if (tid < 64) {
      float cr = 0.f, cim = 0.f;
      for (int q2 = 0; q2 < 4; ++q2) {
        const int cnt = min(max(ci - q2 * 8, 0), 8);
        for (int k = 0; k < cnt; ++k) { const float nr = l64r * cr - l64i * cim, ni = l64r * cim + l64i * cr; cr = nr; cim = ni; }
        cr += part[(q2 * 64 + p) * 2]; cim += part[(q2 * 64 + p) * 2 + 1];
      }
      car[p * 2] = cr; car[p * 2 + 1] = cim;
    }
    __syncthreads();
  }
#pragma unroll
  for (int q = 0; q < 2; ++q) {
    const int sg = tq + 4 * q;
    const int sseq = (tok0 - TP) / 8 + sg;
    float sr, si;
    if (isS) {
      sr = st0[2 * q]; si = st0[2 * q + 1];
    } else {
      sr = car[p * 2]; si = car[p * 2 + 1];
      for (int s2 = 0; s2 < sg; ++s2) {
        const float nr = l8r * sr - l8i * si + segS[(s2 * 64 + p) * 2];
        const float ni = l8r * si + l8i * sr + segS[(s2 * 64 + p) * 2 + 1];
        sr = nr; si = ni;
      }
    }
#pragma unroll
    for (int tt = 0; tt < 8; ++tt) {
      const int t = sg * 8 + tt;
      const float nr = lr * sr - li * si + bu_s[t * 128 + p];
      const float ni = lr * si + li * sr + bu_s[t * 128 + 64 + p];
      sr = nr; si = ni;
      ss_b[t * 136 + p] = f2bf(sr);
      ss_b[t * 136 + 64 + p] = f2bf(si);
    }
    if (isS) {
      const size_t so = ((size_t)(l * 128 + sseq) * 32 + g) * 64 + p;
      P.out[O_SSR + so] = sr; P.out[O_SSI + so] = si;
    } else if ((chunk & 31) == 31 && sg == 7) {
      const size_t so = ((size_t)(l * 8 + (chunk >> 5)) * 32 + g) * 64 + p;
      P.out[O_PSR + so] = sr; P.out[O_PSI + so] = si;
    }
  }
  __syncthreads();
  {
    f32x4 acc = {0.f, 0.f, 0.f, 0.f};
#pragma unroll
    for (int ks = 0; ks < 4; ++ks) {
      const bf16x8 a = *(const bf16x8*)(ss_b + (wid * 16 + (lane & 15)) * 136 + ks * 32 + (lane >> 4) * 8);
      acc = MFMA16(a, cfr[ks], acc);
    }
    const int h = hh;
#pragma unroll
    for (int r = 0; r < 4; ++r) {
      const int t = wid * 16 + (lane >> 4) * 4 + r;
      PJ[(size_t)(tok0 + t) * NPJ + C_S5U + g * 16 + h] = f2bf(geluf(acc[r] + dco * uu[r]));
    }
  }
}

DI void gdn_conv_col(const Params& P, int l, int chunk, int ch, float (&v)[64]) {
  const bfu* PJ = (const bfu*)(P.ws + WS_PROJ);
  const int tok0 = chunk * 64;
  const bool isS = chunk >= 256;
  const float* cw = P.in[32] + l * 4 * 1536;
  const float w0 = cw[ch], w1 = cw[1536 + ch], w2 = cw[2 * 1536 + ch], w3 = cw[3 * 1536 + ch];
  float x3 = 0.f, x2 = 0.f, x1 = 0.f;
  if (!isS && (chunk & 31) != 0) {
    x3 = bf2f(PJ[(size_t)(tok0 - 3) * NPJ + C_QKV + ch]);
    x2 = bf2f(PJ[(size_t)(tok0 - 2) * NPJ + C_QKV + ch]);
    x1 = bf2f(PJ[(size_t)(tok0 - 1) * NPJ + C_QKV + ch]);
  }
#pragma unroll
  for (int sg = 0; sg < 8; ++sg) {
    if (isS) {
      const float* st = P.in[6] + ((size_t)(l * 128 + (chunk - 256) * 8 + sg) * 3) * 1536 + ch;
      x3 = st[0]; x2 = st[1536]; x1 = st[2 * 1536];
    }
#pragma unroll
    for (int tt = 0; tt < 8; ++tt) {
      const int t = sg * 8 + tt;
      const float x = bf2f(PJ[(size_t)(tok0 + t) * NPJ + C_QKV + ch]);
      v[t] = siluf(w0 * x3 + w1 * x2 + w2 * x1 + w3 * x);
      x3 = x2; x2 = x1; x1 = x;
    }
  }
}

DI void gdn1_task(const Params& P, int l, int chunk, int head, char* smem) {
  bfu* qn_b = (bfu*)smem;
  bfu* kn_b = qn_b + 64 * 136;
  float* L_s = (float*)(kn_b + 64 * 136);
  float* rq = L_s + 4096;
  float* rk = rq + 64;
  float* sbeta = rk + 64;
  float* sg_ = sbeta + 64;
  float* gcs = sg_ + 64;
  float* eg = gcs + 64;
  float* gl = eg + 64;
  const int tid = otid(), lane = tid & 63, wid = tid >> 6;
  const bfu* PJ = (const bfu*)(P.ws + WS_PROJ);
  const int tok0 = chunk * 64;
  const bool isS = chunk >= 256;
  float v[64];
  gdn_conv_col(P, l, chunk, (tid < 128) ? (head * 128 + tid) : (512 + head * 128 + (tid - 128)), v);
  {
    bfu* dstb = (tid < 128) ? (qn_b + tid) : (kn_b + (tid - 128));
#pragma unroll
    for (int t = 0; t < 64; ++t) dstb[t * 136] = f2bf(v[t]);
  }
  if (tid < 64) {
    const float* AB = (const float*)(P.ws + WS_AB) + (size_t)(tok0 + tid) * 8;
    sbeta[tid] = sigm(AB[4 + head]);
    sg_[tid] = -__expf(P.in[33][l * 4 + head]) * softplusf(AB[head] + P.in[34][l * 4 + head]);
  }
  __syncthreads();
  if (tid < 128) {
    const bfu* rowp = (tid < 64 ? qn_b : kn_b) + (tid & 63) * 136;
    float s = 0.f;
    for (int d = 0; d < 128; ++d) { const float x = bf2f(rowp[d]); s += x * x; }
    if (tid < 64) rq[tid] = rsqrtf(s + 1e-6f) * 0.08838834764831845f;
    else rk[tid - 64] = rsqrtf(s + 1e-6f);
  } else if (tid < 136) {
    const int sg = tid - 128;
    if (isS) {
      float a = 0.f;
      for (int tt = 0; tt < 8; ++tt) { a += sg_[sg * 8 + tt]; gcs[sg * 8 + tt] = a; eg[sg * 8 + tt] = __expf(a); }
      gl[sg] = a;
    } else if (sg == 0) {
      float a = 0.f;
      for (int t = 0; t < 64; ++t) { a += sg_[t]; gcs[t] = a; eg[t] = __expf(a); }
      for (int s2 = 0; s2 < 8; ++s2) gl[s2] = a;
    }
  }
  __syncthreads();
  if (tid < 128) {
    bfu* QG = (bfu*)(P.ws + WS_GQG) + (size_t)tok0 * 512 + head * 128 + tid;
#pragma unroll
    for (int t = 0; t < 64; ++t) QG[(size_t)t * 512] = f2bf(v[t] * rq[t] * eg[t]);
    gdn_conv_col(P, l, chunk, 1024 + head * 128 + tid, v);
  } else {
    bfu* KD = (bfu*)(P.ws + WS_GKD) + (size_t)(chunk * 4 + head) * 8192 + (size_t)(tid - 128) * 64;
#pragma unroll
    for (int t8 = 0; t8 < 8; ++t8) {
      float kd[8];
#pragma unroll
      for (int e = 0; e < 8; ++e) {
        const int t = t8 * 8 + e;
        kd[e] = v[t] * rk[t] * __expf(gl[isS ? t8 : 0] - gcs[t]);
      }
      uint4 pk;
      pk.x = pk2(kd[0], kd[1]); pk.y = pk2(kd[2], kd[3]); pk.z = pk2(kd[4], kd[5]); pk.w = pk2(kd[6], kd[7]);
      *(uint4*)(KD + t8 * 8) = pk;
    }
  }
  {
    bfu* QK = (bfu*)(P.ws + WS_GQK) + (size_t)(chunk * 4 + head) * 4096;
    const int mt = wid >> 1, nt = wid & 1;
    f32x16 KK, QQ;
#pragma unroll
    for (int r = 0; r < 16; ++r) { KK[r] = 0.f; QQ[r] = 0.f; }
#pragma unroll
    for (int ks = 0; ks < 8; ++ks) {
      const bf16x8 ak = *(const bf16x8*)(kn_b + (mt * 32 + (lane & 31)) * 136 + ks * 16 + (lane >> 5) * 8);
      const bf16x8 aq = *(const bf16x8*)(qn_b + (mt * 32 + (lane & 31)) * 136 + ks * 16 + (lane >> 5) * 8);
      const bf16x8 bk = *(const bf16x8*)(kn_b + (nt * 32 + (lane & 31)) * 136 + ks * 16 + (lane >> 5) * 8);
      KK = MFMA32(ak, bk, KK);
      QQ = MFMA32(aq, bk, QQ);
    }
    const int j = nt * 32 + (lane & 31);
    const float gcj = gcs[j], rkj = rk[j];
#pragma unroll
    for (int r = 0; r < 16; ++r) {
      const int i = mt * 32 + rowmap(r, lane);
      const bool ok = (i >= j) && (!isS || ((i >> 3) == (j >> 3)));
      const float dec = ok ? __expf(gcs[i] - gcj) : 0.f;
      L_s[i * 64 + j] = (i > j) ? sbeta[i] * (rk[i] * rkj * KK[r]) * dec : 0.f;
      QK[i * 64 + j] = f2bf(rq[i] * rkj * QQ[r] * dec);
    }
  }
  __syncthreads();
  {
    if (tid < 128) {
#pragma unroll
      for (int t = 0; t < 64; ++t) v[t] *= sbeta[t];
    } else {
#pragma unroll
      for (int t = 0; t < 64; ++t) v[t] *= rk[t] * sbeta[t] * eg[t];
    }
#pragma unroll
    for (int i = 1; i < 64; ++i) {
      float s = v[i];
#pragma unroll
      for (int j4 = 0; j4 <= (i - 1) / 4; ++j4) {
        const float4 lv = *(const float4*)(L_s + i * 64 + j4 * 4);
        s -= lv.x * v[j4 * 4];
        if (j4 * 4 + 1 < i) s -= lv.y * v[j4 * 4 + 1];
        if (j4 * 4 + 2 < i) s -= lv.z * v[j4 * 4 + 2];
        if (j4 * 4 + 3 < i) s -= lv.w * v[j4 * 4 + 3];
      }
      v[i] = s;
    }
    bfu* dst = (bfu*)(P.ws + (tid < 128 ? WS_GU : WS_GW)) + (size_t)tok0 * 512 + head * 128 + (tid & 127);
#pragma unroll
    for (int t = 0; t < 64; ++t) dst[(size_t)t * 512] = f2bf(v[t]);
  }
  if (tid < 8) ((float*)(P.ws + WS_GDEC))[(chunk * 4 + head) * 32 + tid] = __expf(gl[tid]);
  if (isS) {
    for (int idx = tid; idx < 8 * 3 * 384; idx += 256) {
      const int cq = idx % 384, i = (idx / 384) % 3, sg = idx / 1152;
      const int ch = (cq >> 7) * 512 + head * 128 + (cq & 127);
      const int sseq = (chunk - 256) * 8 + sg;
      P.out[O_SGC + ((size_t)(l * 128 + sseq) * 3 + i) * 1536 + ch] = bf2f(PJ[(size_t)(tok0 + sg * 8 + 5 + i) * NPJ + C_QKV + ch]);
    }
  } else if ((chunk & 31) == 31) {
    for (int idx = tid; idx < 3 * 384; idx += 256) {
      const int cq = idx % 384, i = idx / 384;
      const int ch = (cq >> 7) * 512 + head * 128 + (cq & 127);
      P.out[O_PGC + ((size_t)(l * 8 + (chunk >> 5)) * 3 + i) * 1536 + ch] = bf2f(PJ[(size_t)(tok0 + 61 + i) * NPJ + C_QKV + ch]);
    }
  }
}

DI void gdn2_task(const Params& P, int l, int useq, int head, int dvs, char* smem) {
  bfu* Sb = (bfu*)smem;
  bfu* Vn = Sb + 32 * 136;
  const int tid = otid(), lane = tid & 63, w = tid >> 6;
  const bool isS = useq >= 8;
  const int sseq = useq - 8;
  const int nch = isS ? 1 : 32;
  const int chunk0 = isS ? (256 + (sseq >> 3)) : useq * 32;
  const int vseg = isS ? (sseq & 7) : -1;
  const bfu* GW = (const bfu*)(P.ws + WS_GW);
  const bfu* GQ = (const bfu*)(P.ws + WS_GQG);
  const bfu* GU = (const bfu*)(P.ws + WS_GU);
  bfu* PJO = (bfu*)(P.ws + WS_PROJ);
  const bfu* GKD = (const bfu*)(P.ws + WS_GKD);
  const bfu* GQK = (const bfu*)(P.ws + WS_GQK);
  const float* GDEC = (const float*)(P.ws + WS_GDEC);
  const int dv = dvs * 32 + (lane & 31);
  f32x16 S;
  if (isS) {
    const float* s0 = P.in[7] + ((size_t)((l * 128 + sseq) * 4 + head) * 128) * 128 + dv;
#pragma unroll
    for (int r = 0; r < 16; ++r) S[r] = s0[(size_t)(32 * w + rowmap(r, lane)) * 128];
  } else {
#pragma unroll
    for (int r = 0; r < 16; ++r) S[r] = 0.f;
  }
  const bf16x8 zero8 = {0, 0, 0, 0, 0, 0, 0, 0};
  for (int ci = 0; ci < nch; ++ci) {
    const int chunk = chunk0 + ci, tok0 = chunk * 64;
    const int mt = w & 1;
    const int row = mt * 32 + (lane & 31);
    const bool rvalid = !isS || ((row >> 3) == vseg);
    bf16x8 aA[8], aQ[4], aK[4];
    float uu[16];
    {
      const bfu* Ab = (w < 2 ? GW : GQ) + (size_t)(tok0 + row) * 512 + head * 128 + (lane >> 5) * 8;
#pragma unroll
      for (int ks = 0; ks < 8; ++ks) aA[ks] = rvalid ? *(const bf16x8*)(Ab + ks * 16) : zero8;
      const bfu* Kb = GKD + ((size_t)(chunk * 4 + head) * 128 + 32 * w + (lane & 31)) * 64 + (lane >> 5) * 8;
#pragma unroll
      for (int ks = 0; ks < 4; ++ks) {
        const bool gv = !isS || ((ks * 2 + (lane >> 5)) == vseg);
        aK[ks] = gv ? *(const bf16x8*)(Kb + ks * 16) : zero8;
      }
      if (w >= 2) {
        const bfu* Qb = GQK + ((size_t)(chunk * 4 + head) * 64 + row) * 64 + (lane >> 5) * 8;
#pragma unroll
        for (int ks = 0; ks < 4; ++ks) aQ[ks] = rvalid ? *(const bf16x8*)(Qb + ks * 16) : zero8;
#pragma unroll
        for (int r = 0; r < 16; ++r) uu[r] = 0.f;
      } else {
#pragma unroll
        for (int ks = 0; ks < 4; ++ks) aQ[ks] = zero8;
#pragma unroll
        for (int r = 0; r < 16; ++r) {
          const int t = mt * 32 + rowmap(r, lane);
          const bool tv = !isS || ((t >> 3) == vseg);
          uu[r] = tv ? bf2f(GU[(size_t)(tok0 + t) * 512 + head * 128 + dv]) : 0.f;
        }
      }
    }
    const float gdec = GDEC[(chunk * 4 + head) * 32 + (isS ? vseg : 0)];
    __syncthreads();
#pragma unroll
    for (int g4 = 0; g4 < 4; ++g4) {
      uint2 pk;
      pk.x = pk2(S[4 * g4], S[4 * g4 + 1]); pk.y = pk2(S[4 * g4 + 2], S[4 * g4 + 3]);
      *(uint2*)(Sb + (lane & 31) * 136 + 32 * w + 8 * g4 + 4 * (lane >> 5)) = pk;
    }
    __syncthreads();
    f32x16 acc;
#pragma unroll
    for (int r = 0; r < 16; ++r) acc[r] = 0.f;
#pragma unroll
    for (int ks = 0; ks < 8; ++ks) {
      const bf16x8 b8 = *(const bf16x8*)(Sb + (lane & 31) * 136 + ks * 16 + (lane >> 5) * 8);
      acc = MFMA32(aA[ks], b8, acc);
    }
    if (w < 2) {
#pragma unroll
      for (int g4 = 0; g4 < 4; ++g4) {
        uint2 pk;
        pk.x = pk2(uu[4 * g4] - acc[4 * g4], uu[4 * g4 + 1] - acc[4 * g4 + 1]);
        pk.y = pk2(uu[4 * g4 + 2] - acc[4 * g4 + 2], uu[4 * g4 + 3] - acc[4 * g4 + 3]);
        *(uint2*)(Vn + (lane & 31) * 72 + mt * 32 + 8 * g4 + 4 * (lane >> 5)) = pk;
      }
    }
    __syncthreads();
    if (w >= 2) {
#pragma unroll
      for (int ks = 0; ks < 4; ++ks) {
        const bf16x8 b8 = *(const bf16x8*)(Vn + (lane & 31) * 72 + ks * 16 + (lane >> 5) * 8);
        acc = MFMA32(aQ[ks], b8, acc);
      }
#pragma unroll
      for (int r = 0; r < 16; ++r) {
        const int t = mt * 32 + rowmap(r, lane);
        const bool tv = !isS || ((t >> 3) == vseg);
        if (tv) PJO[(size_t)(tok0 + t) * NPJ + C_QKV + (head * 4 + dvs) * 64 + (lane & 31)] = f2bf(acc[r]);
      }
    }
    {
#pragma unroll
      for (int r = 0; r < 16; ++r) S[r] *= gdec;
#pragma unroll
      for (int ks = 0; ks < 4; ++ks) {
        const bf16x8 b8 = *(const bf16x8*)(Vn + (lane & 31) * 72 + ks * 16 + (lane >> 5) * 8);
        S = MFMA32(aK[ks], b8, S);
      }
    }
  }
  float* so = P.out + (isS ? (O_SGS + ((size_t)((l * 128 + sseq) * 4 + head) * 128) * 128)
                           : (O_PGS + ((size_t)((l * 8 + useq) * 4 + head) * 128) * 128)) + dv;
#pragma unroll
  for (int r = 0; r < 16; ++r) so[(size_t)(32 * w + rowmap(r, lane)) * 128] = S[r];
}

DI void gdn3_pass(const Params& P, int l) {
  const int tid_ = otid(), lane = tid_ & 63, wid = tid_ >> 6;
  const int nw = gridDim.x * 4, gw = blockIdx.x * 4 + wid;
  const bfu* GU = (const bfu*)(P.ws + WS_GU);
  bfu* PJ = (bfu*)(P.ws + WS_PROJ);
  const float* nwt = P.in[35] + l * 128 + (lane & 15) * 8;
  for (int r = gw; r < T_ALL; r += nw) {
    const uint4 ov = *(const uint4*)(PJ + (size_t)r * NPJ + C_QKV + (lane >> 2) * 64 + (lane & 3) * 8);
    const uint4 zv = *(const uint4*)(PJ + (size_t)r * NPJ + C_Z + lane * 8);
    float o[8], z[8];
    const unsigned ow[4] = {ov.x, ov.y, ov.z, ov.w}, zw[4] = {zv.x, zv.y, zv.z, zv.w};
    float ss = 0.f;
#pragma unroll
    for (int e = 0; e < 4; ++e) {
      o[2 * e] = __uint_as_float(ow[e] << 16); o[2 * e + 1] = __uint_as_float(ow[e] & 0xffff0000u);
      z[2 * e] = __uint_as_float(zw[e] << 16); z[2 * e + 1] = __uint_as_float(zw[e] & 0xffff0000u);
      ss += o[2 * e] * o[2 * e] + o[2 * e + 1] * o[2 * e + 1];
    }
    ss += __shfl_xor(ss, 1, 64); ss += __shfl_xor(ss, 2, 64); ss += __shfl_xor(ss, 4, 64); ss += __shfl_xor(ss, 8, 64);
    const float rn = rsqrtf(ss * (1.f / 128.f) + 1e-6f);
    float res[8];
#pragma unroll
    for (int e = 0; e < 8; ++e) res[e] = o[e] * rn * nwt[e] * siluf(z[e]);
    uint4 pk;
    pk.x = pk2(res[0], res[1]); pk.y = pk2(res[2], res[3]); pk.z = pk2(res[4], res[5]); pk.w = pk2(res[6], res[7]);
    *(uint4*)(PJ + (size_t)r * NPJ + C_Z + lane * 8) = pk;
  }
}

DI void phase_mix1a(const Params& P, int l, char* smem) {
  for (int t = blockIdx.x; t < 1088; t += gridDim.x) {
    __syncthreads();
    gdn1_task(P, l, t >> 2, t & 3, smem);
  }
}
DI void phase_mix1b(const Params& P, int l, char* smem) {
  const int NT = 2048 + 8192;
  for (int t = blockIdx.x; t < NT; t += gridDim.x) {
    __syncthreads();
    if (t < 2048) rg_task(P, l, t >> 3, t & 7, 0, smem);
    else { const int r = t - 2048; s5_task(P, l, r >> 5, r & 31, 0, smem); }
  }
}

DI void phase_mix2(const Params& P, int l, char* smem) {
  const int G = gridDim.x;
  for (int t = blockIdx.x; t < 128; t += G) {
    __syncthreads();
    gdn2_task(P, l, t >> 4, (t >> 2) & 3, t & 3, smem);
  }
  unsigned* ctr = (unsigned*)(P.ws + WS_BAR) + XB_WORDS + 64 * (1 + l);
  volatile int* nxt = (volatile int*)(smem + LDS_BYTES - 16);
  const int NR = 2176 + 2176 + 2048;
  for (;;) {
    __syncthreads();
    if (threadIdx.x == 0) *nxt = (int)__hip_atomic_fetch_add(ctr, 1u, __ATOMIC_RELAXED, __HIP_MEMORY_SCOPE_AGENT);
    __syncthreads();
    const int r = *nxt;
    if (r >= NR) break;
    __syncthreads();
    if (r < 2176) {
#pragma unroll 1
      for (int gg = 0; gg < 4; ++gg) { if (gg) __syncthreads(); s5_task(P, l, r >> 3, (r & 7) * 4 + gg, 1, smem); }
    } else if (r < 4352) { const int q = r - 2176; rg_task(P, l, q >> 3, q & 7, 1, smem); }
    else { const int q = r - 4352; gdn2_task(P, l, 8 + (q >> 4), (q >> 2) & 3, q & 3, smem); }
  }
}

__global__ void __launch_bounds__(256, 2) mega_kernel(Params P) {
  extern __shared__ __attribute__((aligned(16))) char smem[];
  cg::grid_group grid = cg::this_grid();
  char* ws = P.ws;
  if (P.out == nullptr) grid.sync();
  GBar gb;
  gbar_init(gb, (unsigned*)(ws + WS_BAR));
  prep_layer(P, 0, smem);
  norm_pass(P, 0, 0, smem);
  gsync(gb);
#pragma unroll 1
  for (int l = 0; l < 2; ++l) {
    gemm_plain((const bfu*)(ws + WS_H), 1024, (const bfu*)(ws + WS_WIN), 1024, 1024, 3584, (bfu*)(ws + WS_PROJ), NPJ, smem);
    gsync(gb);
    phase_mix1b(P, l, smem);
    gsync(gb);
    phase_mix1a(P, l, smem);
    gsync(gb);
    phase_mix2(P, l, smem);
    gsync(gb);
    gemm_glu(P, l, smem);
    gdn3_pass(P, l);
    gsync(gb);
    gemm_merge(P, smem);
    gsync(gb);
    gemm_plain((const bfu*)(ws + WS_MIXED), 1024, (const bfu*)(ws + WS_WOUT), 1024, 1024, 1024, (bfu*)(ws + WS_MO), 1024, smem);
    gsync(gb);
    norm_pass(P, l, 1, smem);
    gsync(gb);
    gemm_ffn1(P, smem);
    gsync(gb);
    gemm_plain((const bfu*)(ws + WS_ACT), 2816, (const bfu*)(ws + WS_WDN), 2816, 2816, 1024, (bfu*)(ws + WS_FO), 1024, smem);
    gsync(gb);
    norm_pass(P, l, 2, smem);
    if (l == 0) prep_layer(P, 1, smem);
    gsync(gb);
  }
}

extern "C" void kernel_launch(void* const* d_in, const int* in_sizes, int n_in, void* d_out, int out_size, void* d_ws, size_t ws_size,
                              hipStream_t stream) {
  static int grid_blocks = 0;
  if (!grid_blocks) {
    int dev = 0, cus = 0, per_cu = 0;
    hipGetDevice(&dev);
    hipDeviceGetAttribute(&cus, hipDeviceAttributeMultiprocessorCount, dev);
    hipFuncSetAttribute((const void*)mega_kernel, hipFuncAttributeMaxDynamicSharedMemorySize, LDS_BYTES);
    hipOccupancyMaxActiveBlocksPerMultiprocessor(&per_cu, mega_kernel, 256, LDS_BYTES);
    if (per_cu > 2) per_cu = 2;
    if (per_cu < 1) per_cu = 1;
    grid_blocks = cus * per_cu;
    grid_blocks &= ~7;
  }
  if (ws_size < WS_END) { fprintf(stderr, "workspace too small: %zu < %zu\n", ws_size, (size_t)WS_END); return; }
  Params p{};
  for (int i = 0; i < 41; ++i) p.in[i] = (const float*)d_in[i];
  p.out = (float*)d_out;
  p.ws = (char*)d_ws;
  hipMemsetAsync((char*)d_ws + WS_BAR, 0, 16384, stream);
  void* args[] = {&p};
  hipError_t e = hipLaunchCooperativeKernel((const void*)mega_kernel, dim3(grid_blocks), dim3(256), args, LDS_BYTES, stream);
  if (e != hipSuccess) fprintf(stderr, "cooperative launch failed: %s (grid %d)\n", hipGetErrorString(e), grid_blocks);
}
```

```cpp
#include <hip/hip_runtime.h>
#include <hip/hip_cooperative_groups.h>
#include <cstdio>
namespace cg = cooperative_groups;

typedef unsigned short bfu;
using bf16x8 = __attribute__((ext_vector_type(8))) short;
using f32x16 = __attribute__((ext_vector_type(16))) float;
using f32x4  = __attribute__((ext_vector_type(4))) float;
using u32x4  = __attribute__((ext_vector_type(4))) unsigned;
#define DI __device__ __forceinline__
#define MFMA32(a, b, c) __builtin_amdgcn_mfma_f32_32x32x16_bf16((a), (b), (c), 0, 0, 0)
#define MFMA16(a, b, c) __builtin_amdgcn_mfma_f32_16x16x32_bf16((a), (b), (c), 0, 0, 0)

constexpr int T_ALL = 17408, TP = 16384, NPJ = 3584;
constexpr int C_RGX = 0, C_RGG = 512, C_S5U = 1024, C_QKV = 1536, C_Z = 3072;
constexpr int LDS_BYTES = 65536;

constexpr size_t O_PRC = 17825792, O_PRH = O_PRC + 24576, O_PSR = O_PRH + 8192, O_PSI = O_PSR + 32768,
                 O_PGC = O_PSI + 32768, O_PGS = O_PGC + 73728, O_SRC = O_PGS + 1048576, O_SRH = O_SRC + 393216,
                 O_SSR = O_SRH + 131072, O_SSI = O_SSR + 524288, O_SGC = O_SSI + 524288, O_SGS = O_SGC + 1179648;

constexpr size_t WS_WIN = 0;
constexpr size_t WS_RGO = WS_WIN + (size_t)6656 * 1024 * 2;
constexpr size_t WS_S5O = WS_RGO + (size_t)1024 * 512 * 2;
constexpr size_t WS_GDO = WS_S5O + (size_t)1024 * 512 * 2;
constexpr size_t WS_GLU = WS_GDO + (size_t)1024 * 512 * 2;
constexpr size_t WS_WOUT = WS_GLU + (size_t)512 * 512 * 2;
constexpr size_t WS_WGU = WS_WOUT + (size_t)1024 * 1024 * 2;
constexpr size_t WS_WDN = WS_WGU + (size_t)5632 * 1024 * 2;
constexpr size_t WS_RGW = WS_WDN + (size_t)1024 * 2816 * 2;
constexpr size_t WS_S5BB = WS_RGW + (size_t)8 * 128 * 64 * 2;
constexpr size_t WS_S5CC = WS_S5BB + (size_t)65536 * 2;
constexpr size_t WS_S5LAM = WS_S5CC + (size_t)65536 * 2;
constexpr size_t WS_H = WS_S5LAM + (size_t)4096 * 4;
constexpr size_t WS_PROJ = WS_H + (size_t)T_ALL * 1024 * 2;
constexpr size_t WS_GQG = WS_PROJ + (size_t)T_ALL * NPJ * 2;
constexpr size_t WS_GU = WS_GQG + (size_t)T_ALL * 512 * 2;
constexpr size_t WS_GW = WS_GU + (size_t)T_ALL * 512 * 2;
constexpr size_t WS_GKD = WS_GW + (size_t)T_ALL * 512 * 2;
constexpr size_t WS_GQK = WS_GKD + (size_t)272 * 4 * 128 * 64 * 2;
constexpr size_t WS_AB = WS_GQK + (size_t)272 * 4 * 64 * 64 * 2;
constexpr size_t WS_RGSUM = WS_AB + (size_t)T_ALL * 8 * 4;
constexpr size_t WS_S5SUM = WS_RGSUM + (size_t)256 * 512 * 2 * 4;
constexpr size_t WS_GDEC = WS_S5SUM + (size_t)256 * 32 * 64 * 2 * 4;
constexpr size_t WS_BAR = WS_GDEC + (size_t)272 * 4 * 32 * 4;
constexpr size_t WS_END = WS_BAR + 16384;
constexpr size_t WS_MIXED = WS_GQG, WS_MO = WS_PROJ, WS_ACT = WS_PROJ, WS_FO = WS_GQG;

struct Params {
  const float* in[41];
  float* out;
  char* ws;
};

DI int otid() { int t = threadIdx.x; asm volatile("" : "+v"(t)); return t; }
DI bfu f2bf(float x) { unsigned u = __float_as_uint(x); u += 0x7fffu + ((u >> 16) & 1u); return (bfu)(u >> 16); }
DI float bf2f(bfu v) { return __uint_as_float(((unsigned)v) << 16); }
DI unsigned pk2(float a, float b) { return (unsigned)f2bf(a) | ((unsigned)f2bf(b) << 16); }
DI float sigm(float x) { return 1.f / (1.f + __expf(-x)); }
DI float siluf(float x) { return x * sigm(x); }
DI float geluf(float x) { float u = 0.7978845608028654f * (x + 0.044715f * x * x * x); float t = __expf(2.f * u); return 0.5f * x * (2.f - 2.f / (t + 1.f)); }
DI float softplusf(float x) { return fmaxf(x, 0.f) + log1pf(__expf(-fabsf(x))); }
DI float wsum(float v) { for (int o = 32; o > 0; o >>= 1) v += __shfl_xor(v, o, 64); return v; }
DI int rowmap(int reg, int lane) { return (reg & 3) + 8 * (reg >> 2) + 4 * (lane >> 5); }

template <int MT>
DI void gemm_tile(const bfu* __restrict__ A, int lda, const bfu* __restrict__ W, int ldw, int K, f32x16 (&acc)[MT][2], char* smem) {
  constexpr int BM = 64 * MT, LS = 72;
  bfu* As = (bfu*)smem;
  bfu* Ws = As + BM * LS;
  const int tid = otid(), lane = tid & 63, wid = tid >> 6, wm = wid >> 1, wn = wid & 1;
  const int lr = tid >> 3, lc = tid & 7;
  u32x4 ra[2 * MT], rw[4];
  const bfu* Ap = A + (size_t)lr * lda + lc * 8;
  const bfu* Wp = W + (size_t)lr * ldw + lc * 8;
#pragma unroll
  for (int i = 0; i < 2 * MT; ++i) ra[i] = *(const u32x4*)(Ap + (size_t)i * 32 * lda);
#pragma unroll
  for (int i = 0; i < 4; ++i) rw[i] = *(const u32x4*)(Wp + (size_t)i * 32 * ldw);
  const int nk = K >> 6;
  const int arow = wm * 32 * MT + (lane & 31), wrow = wn * 64 + (lane & 31), kof = (lane >> 5) * 8;
  for (int kt = 0; kt < nk; ++kt) {
    __syncthreads();
#pragma unroll
    for (int i = 0; i < 2 * MT; ++i) *(u32x4*)(As + (lr + 32 * i) * LS + lc * 8) = ra[i];
#pragma unroll
    for (int i = 0; i < 4; ++i) *(u32x4*)(Ws + (lr + 32 * i) * LS + lc * 8) = rw[i];
    if (kt + 1 < nk) {
      Ap += 64; Wp += 64;
#pragma unroll
      for (int i = 0; i < 2 * MT; ++i) ra[i] = *(const u32x4*)(Ap + (size_t)i * 32 * lda);
#pragma unroll
      for (int i = 0; i < 4; ++i) rw[i] = *(const u32x4*)(Wp + (size_t)i * 32 * ldw);
    }
    __syncthreads();
#pragma unroll
    for (int ks = 0; ks < 4; ++ks) {
      bf16x8 af[MT], wf[2];
#pragma unroll
      for (int mt = 0; mt < MT; ++mt) af[mt] = *(const bf16x8*)(As + (arow + mt * 32) * LS + ks * 16 + kof);
#pragma unroll
      for (int nt = 0; nt < 2; ++nt) wf[nt] = *(const bf16x8*)(Ws + (wrow + nt * 32) * LS + ks * 16 + kof);
#pragma unroll
      for (int mt = 0; mt < MT; ++mt)
#pragma unroll
        for (int nt = 0; nt < 2; ++nt) acc[mt][nt] = MFMA32(wf[nt], af[mt], acc[mt][nt]);
    }
  }
}

template <int MT>
DI void zero_acc(f32x16 (&acc)[MT][2]) {
#pragma unroll
  for (int mt = 0; mt < MT; ++mt)
#pragma unroll
    for (int nt = 0; nt < 2; ++nt)
#pragma unroll
      for (int r = 0; r < 16; ++r) acc[mt][nt][r] = 0.f;
}

#define XB_SIMPLE 0
#define XB_CNT(j) (64 * (1 + (j)))
#define XB_XSUB(j) (64 * (17 + (j)))
#define XB_XGEN(j) (64 * (33 + (j)))
#define XB_TOP (64 * 49)
#define XB_TOPGEN (64 * 50)
#define XB_WORDS (64 * 51)
struct GBar { unsigned* w; unsigned x, nloc, nx, k; };
DI unsigned xb_ld(unsigned* p) { return __hip_atomic_load(p, __ATOMIC_RELAXED, __HIP_MEMORY_SCOPE_AGENT); }
DI unsigned xb_add(unsigned* p, unsigned v) { return __hip_atomic_fetch_add(p, v, __ATOMIC_RELAXED, __HIP_MEMORY_SCOPE_AGENT); }
DI void gbar_init(GBar& b, unsigned* w) {
  b.w = w; b.k = 0; b.nloc = 1; b.nx = 1;
  b.x = (unsigned)__builtin_amdgcn_s_getreg((3 << 11) | 20) & 0xFu;
  if (threadIdx.x == 0) {
    const unsigned r0 = xb_add(&w[XB_CNT(b.x)], 1u);
    asm volatile("s_waitcnt vmcnt(0)" ::"v"(r0) : "memory");
    xb_add(&w[XB_SIMPLE], 1u);
    while (xb_ld(&w[XB_SIMPLE]) < gridDim.x) __builtin_amdgcn_s_sleep(1);
    unsigned mine = 1u, cnt = 0u;
    for (unsigned j = 0; j < 16; ++j) { const unsigned c = xb_ld(&w[XB_CNT(j)]); cnt += (c > 0u) ? 1u : 0u; mine = (j == b.x) ? c : mine; }
    b.nloc = mine; b.nx = cnt;
  }
  __syncthreads();
}
DI void gsync(GBar& b) {
  asm volatile("s_waitcnt vmcnt(0)" ::: "memory");
  __syncthreads();
  if (threadIdx.x == 0) {
    unsigned* w = b.w;
    const unsigned gen = b.k;
    const unsigned old = xb_add(&w[XB_XSUB(b.x)], 1u);
    if (old + 1u == (gen + 1u) * b.nloc) {
      __builtin_amdgcn_fence(__ATOMIC_RELEASE, "agent");
      asm volatile("s_waitcnt vmcnt(0)" ::: "memory");
      const unsigned og = xb_add(&w[XB_TOP], 1u);
      if (og + 1u == (gen + 1u) * b.nx) xb_add(&w[XB_TOPGEN], 1u);
      else while (xb_ld(&w[XB_TOPGEN]) == gen) __builtin_amdgcn_s_sleep(1);
      __builtin_amdgcn_fence(__ATOMIC_ACQUIRE, "agent");
      xb_add(&w[XB_XGEN(b.x)], 1u);
      asm volatile("s_waitcnt vmcnt(0)" ::: "memory");
    } else {
      while (xb_ld(&w[XB_XGEN(b.x)]) == gen) __builtin_amdgcn_s_sleep(1);
      __builtin_amdgcn_fence(__ATOMIC_ACQUIRE, "agent");
      asm volatile("s_waitcnt vmcnt(0)" ::: "memory");
    }
  }
  b.k += 1;
  __syncthreads();
}

DI bool tile_map(int it, int nM, int nN, int& tm, int& tn) {
  const int ntiles = nM * nN, per = (ntiles + 7) >> 3;
  const int xcd = blockIdx.x & 7, local = (blockIdx.x >> 3) + it * (gridDim.x >> 3);
  if (local >= per) return false;
  const int q = xcd * per + local;
  if (q >= ntiles) return false;
  const int grp = q / (8 * nN), fm = grp * 8, gsz = min(nM - fm, 8), within = q - grp * 8 * nN;
  tm = fm + within % gsz; tn = within / gsz;
  return true;
}

DI void tile_of(int q, int nM, int nN, int& tm, int& tn) {
  const int grp = q / (8 * nN), fm = grp * 8, gsz = min(nM - fm, 8), within = q - grp * 8 * nN;
  tm = fm + within % gsz; tn = within / gsz;
}
template <int MT>
DI void plain_tile(const bfu* A, int lda, const bfu* W, int ldw, int K, bfu* C, int ldc, int m0, int n0, char* smem) {
  const int tid_ = otid(), lane = tid_ & 63, wid = tid_ >> 6, wm = wid >> 1, wn = wid & 1;
  f32x16 acc[MT][2];
  zero_acc<MT>(acc);
  gemm_tile<MT>(A + (size_t)m0 * lda, lda, W + (size_t)n0 * ldw, ldw, K, acc, smem);
  __syncthreads();
  {
    char* cs = smem;
#pragma unroll
    for (int mt = 0; mt < MT; ++mt) {
      const int m = wm * 32 * MT + mt * 32 + (lane & 31), sw = m & 31;
#pragma unroll
      for (int nt = 0; nt < 2; ++nt)
#pragma unroll
        for (int g4 = 0; g4 < 4; ++g4) {
          const int c8 = (wn * 64 + nt * 32 + 8 * g4 + 4 * (lane >> 5)) >> 2;
          uint2 pk;
          pk.x = pk2(acc[mt][nt][4 * g4], acc[mt][nt][4 * g4 + 1]);
          pk.y = pk2(acc[mt][nt][4 * g4 + 2], acc[mt][nt][4 * g4 + 3]);
          *(uint2*)(cs + m * 256 + ((c8 ^ sw) << 3)) = pk;
        }
    }
  }
  __syncthreads();
  {
    const char* cs = smem;
    const int jj = tid_ & 15;
#pragma unroll
    for (int i = 0; i < 4 * MT; ++i) {
      const int row = (tid_ >> 4) + 16 * i, sw = row & 31;
      uint4 v = *(const uint4*)(cs + row * 256 + ((jj ^ (sw >> 1)) << 4));
      if (sw & 1) { const unsigned t0 = v.x, t1 = v.y; v.x = v.z; v.y = v.w; v.z = t0; v.w = t1; }
      *(uint4*)(C + (size_t)(m0 + row) * ldc + n0 + jj * 8) = v;
    }
  }
}
DI void gemm_plain(const bfu* A, int lda, const bfu* W, int ldw, int K, int N, bfu* C, int ldc, char* smem) {
  const int nM = T_ALL / 256, nN = N / 128, ntiles = nM * nN, G = gridDim.x;
  const int rem = ntiles % G;
  const bool split = (rem > 0) && (rem * 4 <= G) && ((G & 7) == 0);
  if (!split) {
    for (int it = 0;; ++it) {
      int tm, tn;
      if (!tile_map(it, nM, nN, tm, tn)) break;
      plain_tile<4>(A, lda, W, ldw, K, C, ldc, tm * 256, tn * 128, smem);
    }
    return;
  }
  const int nfull = ntiles - rem, per = nfull >> 3;
  const int xcd = blockIdx.x & 7, slots = G >> 3;
  for (int local = blockIdx.x >> 3; local < per; local += slots) {
    int tm, tn;
    tile_of(xcd * per + local, nM, nN, tm, tn);
    plain_tile<4>(A, lda, W, ldw, K, C, ldc, tm * 256, tn * 128, smem);
  }
  for (int sidx = blockIdx.x; sidx < rem * 4; sidx += G) {
    int tm, tn;
    tile_of(nfull + (sidx >> 2), nM, nN, tm, tn);
    plain_tile<1>(A, lda, W, ldw, K, C, ldc, tm * 256 + (sidx & 3) * 64, tn * 128, smem);
  }
}

DI void gemm_glu(const Params& P, int l, char* smem) {
  bfu* PJ = (bfu*)(P.ws + WS_PROJ);
  const bfu* W = (const bfu*)(P.ws + WS_GLU);
  const float* gb = P.in[30] + l * 512;
  const int nM = T_ALL / 256, nN = 4;
  const int tid_ = otid(), lane = tid_ & 63, wid = tid_ >> 6, wm = wid >> 1, wn = wid & 1;
  for (int it = 0;; ++it) {
    int tm, tn;
    if (!tile_map(it, nM, nN, tm, tn)) break;
    f32x16 acc[4][2];
    zero_acc<4>(acc);
    gemm_tile<4>(PJ + (size_t)tm * 256 * NPJ + C_S5U, NPJ, W + (size_t)tn * 128 * 512, 512, 512, acc, smem);
#pragma unroll
    for (int mt = 0; mt < 4; ++mt) {
      const int m = tm * 256 + wm * 128 + mt * 32 + (lane & 31);
#pragma unroll
      for (int nt = 0; nt < 2; ++nt)
#pragma unroll
        for (int g4 = 0; g4 < 4; ++g4) {
          const int n = tn * 128 + wn * 64 + nt * 32 + 8 * g4 + 4 * (lane >> 5);
          const uint2 yv = *(const uint2*)(PJ + (size_t)m * NPJ + C_S5U + n);
          const float4 bv = *(const float4*)(gb + n);
          const float y0 = bf2f((bfu)(yv.x & 0xffff)), y1 = bf2f((bfu)(yv.x >> 16)), y2 = bf2f((bfu)(yv.y & 0xffff)), y3 = bf2f((bfu)(yv.y >> 16));
          uint2 pk;
          pk.x = pk2(y0 * sigm(acc[mt][nt][4 * g4] + bv.x), y1 * sigm(acc[mt][nt][4 * g4 + 1] + bv.y));
          pk.y = pk2(y2 * sigm(acc[mt][nt][4 * g4 + 2] + bv.z), y3 * sigm(acc[mt][nt][4 * g4 + 3] + bv.w));
          *(uint2*)(PJ + (size_t)m * NPJ + C_RGX + n) = pk;
        }
    }
  }
}

DI void gemm_ffn1(const Params& P, char* smem) {
  const bfu* A = (const bfu*)(P.ws + WS_H);
  const bfu* W = (const bfu*)(P.ws + WS_WGU);
  bfu* C = (bfu*)(P.ws + WS_ACT);
  const int nM = T_ALL / 256, nN = 44;
  const int tid_ = otid(), lane = tid_ & 63, wid = tid_ >> 6, wm = wid >> 1, wn = wid & 1;
  for (int it = 0;; ++it) {
    int tm, tn;
    if (!tile_map(it, nM, nN, tm, tn)) break;
    f32x16 acc[4][2];
    zero_acc<4>(acc);
    gemm_tile<4>(A + (size_t)tm * 256 * 1024, 1024, W + (size_t)tn * 128 * 1024, 1024, 1024, acc, smem);
#pragma unroll
    for (int mt = 0; mt < 4; ++mt) {
      const int m = tm * 256 + wm * 128 + mt * 32 + (lane & 31);
#pragma unroll
      for (int g4 = 0; g4 < 4; ++g4) {
        const int j = tn * 64 + wn * 32 + 8 * g4 + 4 * (lane >> 5);
        uint2 pk;
        pk.x = pk2(siluf(acc[mt][0][4 * g4]) * acc[mt][1][4 * g4], siluf(acc[mt][0][4 * g4 + 1]) * acc[mt][1][4 * g4 + 1]);
        pk.y = pk2(siluf(acc[mt][0][4 * g4 + 2]) * acc[mt][1][4 * g4 + 2], siluf(acc[mt][0][4 * g4 + 3]) * acc[mt][1][4 * g4 + 3]);
        *(uint2*)(C + (size_t)m * 2816 + j) = pk;
      }
    }
  }
}

template <int MT>
DI void merge_tile(const Params& P, int m0, int tn, char* smem) {
  const bfu* H = (const bfu*)(P.ws + WS_H);
  const bfu* PJ = (const bfu*)(P.ws + WS_PROJ);
  const bfu* WIN = (const bfu*)(P.ws + WS_WIN);
  bfu* C = (bfu*)(P.ws + WS_MIXED);
  const int tid_ = otid(), lane = tid_ & 63, wid = tid_ >> 6, wm = wid >> 1, wn = wid & 1;
  f32x16 tot[MT][2];
  zero_acc<MT>(tot);
#pragma unroll 1
  for (int b = 0; b < 3; ++b) {
    unsigned* gps = (unsigned*)(smem + 36864) + tid_;
    unsigned gkeep[4] = {0u, 0u, 0u, 0u};
    {
      f32x16 g[MT][2];
      zero_acc<MT>(g);
      gemm_tile<MT>(H + (size_t)m0 * 1024, 1024, WIN + (size_t)(3584 + b * 1024 + tn * 128) * 1024, 1024, 1024, g, smem);
#pragma unroll
      for (int mt = 0; mt < MT; ++mt)
#pragma unroll
        for (int nt = 0; nt < 2; ++nt)
#pragma unroll
          for (int r = 0; r < 8; ++r) {
            const unsigned pv = pk2(sigm(g[mt][nt][2 * r]), sigm(g[mt][nt][2 * r + 1]));
            if ((mt * 2 + nt) * 8 + r < 28) gps[((mt * 2 + nt) * 8 + r) * 256] = pv;
            else gkeep[((mt * 2 + nt) * 8 + r) - 28] = pv;
          }
    }
    const int colb = (b == 0) ? C_RGG : (b == 1 ? C_RGX : C_Z);
    const bfu* Wo = (const bfu*)(P.ws + (b == 0 ? WS_RGO : (b == 1 ? WS_S5O : WS_GDO)));
    f32x16 y[MT][2];
    zero_acc<MT>(y);
    gemm_tile<MT>(PJ + (size_t)m0 * NPJ + colb, NPJ, Wo + (size_t)tn * 128 * 512, 512, 512, y, smem);
#pragma unroll
    for (int mt = 0; mt < MT; ++mt)
#pragma unroll
      for (int nt = 0; nt < 2; ++nt)
#pragma unroll
        for (int r = 0; r < 8; ++r) {
          const unsigned gv = ((mt * 2 + nt) * 8 + r < 28) ? gps[((mt * 2 + nt) * 8 + r) * 256] : gkeep[((mt * 2 + nt) * 8 + r) - 28];
          tot[mt][nt][2 * r] += __uint_as_float(gv << 16) * y[mt][nt][2 * r];
          tot[mt][nt][2 * r + 1] += __uint_as_float(gv & 0xffff0000u) * y[mt][nt][2 * r + 1];
        }
  }
#pragma unroll
  for (int mt = 0; mt < MT; ++mt) {
    const int m = m0 + wm * 32 * MT + mt * 32 + (lane & 31);
#pragma unroll
    for (int nt = 0; nt < 2; ++nt)
#pragma unroll
      for (int g4 = 0; g4 < 4; ++g4) {
        const int n = tn * 128 + wn * 64 + nt * 32 + 8 * g4 + 4 * (lane >> 5);
        uint2 pk;
        pk.x = pk2(tot[mt][nt][4 * g4], tot[mt][nt][4 * g4 + 1]);
        pk.y = pk2(tot[mt][nt][4 * g4 + 2], tot[mt][nt][4 * g4 + 3]);
        *(uint2*)(C + (size_t)m * 1024 + n) = pk;
      }
  }
}
DI void gemm_merge(const Params& P, char* smem) {
  const int nM = T_ALL / 128, nN = 8, ntiles = nM * nN, G = gridDim.x;
  const int rem = ntiles % G;
  const bool split = (rem > 0) && (rem * 2 <= G / 2) && ((G & 7) == 0);
  if (!split) {
    for (int it = 0;; ++it) {
      int tm, tn;
      if (!tile_map(it, nM, nN, tm, tn)) break;
      merge_tile<2>(P, tm * 128, tn, smem);
    }
    return;
  }
  const int nfull = ntiles - rem, per = nfull >> 3;
  const int xcd = blockIdx.x & 7, slots = G >> 3;
  for (int local = blockIdx.x >> 3; local < per; local += slots) {
    int tm, tn;
    tile_of(xcd * per + local, nM, nN, tm, tn);
    merge_tile<2>(P, tm * 128, tn, smem);
  }
  for (int sidx = blockIdx.x; sidx < rem * 2; sidx += G) {
    int tm, tn;
    tile_of(nfull + (sidx >> 1), nM, nN, tm, tn);
    merge_tile<1>(P, tm * 128 + (sidx & 1) * 64, tn, smem);
  }
}

DI void cvt_job(const float* src, int ld, int K, int ncols, bfu* dst, int ldd, int mode, float* sm) {
  const int nkt = K >> 6, nnt = ncols >> 6, nt = nkt * nnt;
  const int tid = otid();
  for (int t = blockIdx.x; t < nt; t += gridDim.x) {
    const int kt = t % nkt, ct = t / nkt;
    const int k0 = kt * 64, c0 = ct * 64;
    float4 v[4];
#pragma unroll
    for (int i = 0; i < 4; ++i) v[i] = *(const float4*)(src + (size_t)(k0 + (tid >> 4) + 16 * i) * ld + c0 + (tid & 15) * 4);
    __syncthreads();
#pragma unroll
    for (int i = 0; i < 4; ++i) {
      const int k = (tid >> 4) + 16 * i, n = (tid & 15) * 4;
      sm[(n + 0) * 65 + k] = v[i].x; sm[(n + 1) * 65 + k] = v[i].y; sm[(n + 2) * 65 + k] = v[i].z; sm[(n + 3) * 65 + k] = v[i].w;
    }
    __syncthreads();
    const int n = tid >> 2, ks = (tid & 3) * 16;
    const int row = (mode == 0) ? (c0 + n) : (ct * 128 + (n >> 5) * 64 + (mode - 1) * 32 + (n & 31));
    uint4 w0, w1;
    const float* r = sm + n * 65 + ks;
    w0.x = pk2(r[0], r[1]); w0.y = pk2(r[2], r[3]); w0.z = pk2(r[4], r[5]); w0.w = pk2(r[6], r[7]);
    w1.x = pk2(r[8], r[9]); w1.y = pk2(r[10], r[11]); w1.z = pk2(r[12], r[13]); w1.w = pk2(r[14], r[15]);
    *(uint4*)(dst + (size_t)row * ldd + k0 + ks) = w0;
    *(uint4*)(dst + (size_t)row * ldd + k0 + ks + 8) = w1;
  }
}

DI void prep_layer(const Params& P, int l, char* smem) {
  float* sm = (float*)smem;
  char* ws = P.ws;
  cvt_job(P.in[12] + (size_t)l * 1024 * 6664, 6664, 1024, 3584, (bfu*)(ws + WS_WIN), 1024, 0, sm);
  cvt_job(P.in[12] + (size_t)l * 1024 * 6664 + 3592, 6664, 1024, 3072, (bfu*)(ws + WS_WIN) + (size_t)3584 * 1024, 1024, 0, sm);
  cvt_job(P.in[20] + (size_t)l * 512 * 1024, 1024, 512, 1024, (bfu*)(ws + WS_RGO), 512, 0, sm);
  cvt_job(P.in[31] + (size_t)l * 512 * 1024, 1024, 512, 1024, (bfu*)(ws + WS_S5O), 512, 0, sm);
  cvt_job(P.in[36] + (size_t)l * 512 * 1024, 1024, 512, 1024, (bfu*)(ws + WS_GDO), 512, 0, sm);
  cvt_job(P.in[29] + (size_t)l * 512 * 512, 512, 512, 512, (bfu*)(ws + WS_GLU), 512, 0, sm);
  cvt_job(P.in[37] + (size_t)l * 1024 * 1024, 1024, 1024, 1024, (bfu*)(ws + WS_WOUT), 1024, 0, sm);
  cvt_job(P.in[38] + (size_t)l * 1024 * 2816, 2816, 1024, 2816, (bfu*)(ws + WS_WGU), 1024, 1, sm);
  cvt_job(P.in[39] + (size_t)l * 1024 * 2816, 2816, 1024, 2816, (bfu*)(ws + WS_WGU), 1024, 2, sm);
  cvt_job(P.in[40] + (size_t)l * 2816 * 1024, 1024, 2816, 1024, (bfu*)(ws + WS_WDN), 2816, 0, sm);
#pragma unroll 1
  for (int n = 0; n < 8; ++n) {
    cvt_job(P.in[15] + (size_t)(l * 8 + n) * 4096, 64, 64, 64, (bfu*)(ws + WS_RGW) + (size_t)n * 8192, 64, 0, sm);
    cvt_job(P.in[17] + (size_t)(l * 8 + n) * 4096, 64, 64, 64, (bfu*)(ws + WS_RGW) + (size_t)n * 8192 + 4096, 64, 0, sm);
  }
  bfu* BB = (bfu*)(ws + WS_S5BB);
  bfu* CC = (bfu*)(ws + WS_S5CC);
  float* LAM = (float*)(ws + WS_S5LAM);
  for (int idx = blockIdx.x * 256 + otid(); idx < 2048; idx += gridDim.x * 256) {
    const int g = idx >> 6, p = idx & 63;
    const float ar = P.in[21][l * 2048 + idx], ai = P.in[22][l * 2048 + idx];
    const float dt = expf(P.in[28][l * 32 + g]);
    const float mag = expf(ar * dt), ang = ai * dt;
    const float lr = mag * cosf(ang), li = mag * sinf(ang);
    LAM[idx * 2] = lr; LAM[idx * 2 + 1] = li;
    const float den = 1.f / (ar * ar + ai * ai);
    const float cr = ((lr - 1.f) * ar + li * ai) * den, ci = (li * ar - (lr - 1.f) * ai) * den;
    const float* bre = P.in[23] + ((size_t)(l * 32 + g) * 64 + p) * 16;
    const float* bim = P.in[24] + ((size_t)(l * 32 + g) * 64 + p) * 16;
    for (int h = 0; h < 16; ++h) {
      const float br = bre[h], bi = bim[h];
      BB[(size_t)(g * 128 + p) * 16 + h] = f2bf(cr * br - ci * bi);
      BB[(size_t)(g * 128 + 64 + p) * 16 + h] = f2bf(cr * bi + ci * br);
      CC[(size_t)(g * 16 + h) * 128 + p] = f2bf(P.in[25][((size_t)(l * 32 + g) * 16 + h) * 64 + p]);
      CC[(size_t)(g * 16 + h) * 128 + 64 + p] = f2bf(-P.in[26][((size_t)(l * 32 + g) * 16 + h) * 64 + p]);
    }
  }
}

DI void norm_pass(const Params& P, int l, int mode, char* smem) {
  const int tid_ = otid(), lane = tid_ & 63, wid = tid_ >> 6;
  const int nw = gridDim.x * 4, gw = blockIdx.x * 4 + wid;
  const bfu* src = (const bfu*)(P.ws + (mode == 1 ? WS_MO : WS_FO));
  const float* gA = (mode == 1 ? P.in[9] : P.in[11]) + l * 1024;
  const bool doH = (mode != 2) || (l == 0);
  const float* gB = (mode == 0) ? P.in[8] : (mode == 1 ? P.in[10] + l * 1024 : P.in[8] + 1024);
  const bool doAB = (mode == 0) || (mode == 2 && l == 0);
  const int lab = (mode == 0) ? 0 : 1;
  const float* W8 = P.in[12] + (size_t)lab * 1024 * 6664 + 3584;
  bfu* H = (bfu*)(P.ws + WS_H);
  float* AB = (float*)(P.ws + WS_AB);
  float* W8s = (float*)smem;
  if (doAB) {
    __syncthreads();
    for (int idx = tid_; idx < 8192; idx += 256) W8s[(idx & 7) * 1024 + (idx >> 3)] = W8[(size_t)(idx >> 3) * 6664 + (idx & 7)];
    __syncthreads();
  }
  for (int r = gw; r < T_ALL; r += nw) {
    float4 xv[4];
    float* xo = P.out + (size_t)r * 1024;
    if (mode == 0) {
      const float* xi = (r < TP) ? (P.in[0] + (size_t)r * 1024) : (P.in[1] + (size_t)(r - TP) * 1024);
#pragma unroll
      for (int i = 0; i < 4; ++i) xv[i] = *(const float4*)(xi + lane * 4 + 256 * i);
    } else {
      float4 av[4];
      float ss = 0.f;
#pragma unroll
      for (int i = 0; i < 4; ++i) {
        { const f32x4 t4 = __builtin_nontemporal_load((const f32x4*)(xo + lane * 4 + 256 * i)); xv[i] = make_float4(t4[0], t4[1], t4[2], t4[3]); }
        const uint2 s2 = *(const uint2*)(src + (size_t)r * 1024 + lane * 4 + 256 * i);
        av[i].x = bf2f((bfu)(s2.x & 0xffff)); av[i].y = bf2f((bfu)(s2.x >> 16));
        av[i].z = bf2f((bfu)(s2.y & 0xffff)); av[i].w = bf2f((bfu)(s2.y >> 16));
        ss += av[i].x * av[i].x + av[i].y * av[i].y + av[i].z * av[i].z + av[i].w * av[i].w;
      }
      ss = wsum(ss);
      const float sa = rsqrtf(ss * (1.f / 1024.f) + 1e-6f);
#pragma unroll
      for (int i = 0; i < 4; ++i) {
        const float4 gv = *(const float4*)(gA + lane * 4 + 256 * i);
        xv[i].x += av[i].x * sa * gv.x; xv[i].y += av[i].y * sa * gv.y;
        xv[i].z += av[i].z * sa * gv.z; xv[i].w += av[i].w * sa * gv.w;
      }
    }
#pragma unroll
    for (int i = 0; i < 4; ++i) { f32x4 t4 = {xv[i].x, xv[i].y, xv[i].z, xv[i].w}; __builtin_nontemporal_store(t4, (f32x4*)(xo + lane * 4 + 256 * i)); }
    if (doH) {
      float ss = 0.f;
#pragma unroll
      for (int i = 0; i < 4; ++i) ss += xv[i].x * xv[i].x + xv[i].y * xv[i].y + xv[i].z * xv[i].z + xv[i].w * xv[i].w;
      ss = wsum(ss);
      const float sc = rsqrtf(ss * (1.f / 1024.f) + 1e-6f);
      float ab[8];
#pragma unroll
      for (int j = 0; j < 8; ++j) ab[j] = 0.f;
#pragma unroll
      for (int i = 0; i < 4; ++i) {
        const float4 gv = *(const float4*)(gB + lane * 4 + 256 * i);
        float hv[4] = {xv[i].x * sc * gv.x, xv[i].y * sc * gv.y, xv[i].z * sc * gv.z, xv[i].w * sc * gv.w};
        uint2 pk;
        pk.x = pk2(hv[0], hv[1]); pk.y = pk2(hv[2], hv[3]);
        *(uint2*)(H + (size_t)r * 1024 + lane * 4 + 256 * i) = pk;
        if (doAB) {
#pragma unroll
          for (int j = 0; j < 8; ++j) {
            const float4 wj = *(const float4*)(W8s + j * 1024 + lane * 4 + 256 * i);
            ab[j] += hv[0] * wj.x; ab[j] += hv[1] * wj.y; ab[j] += hv[2] * wj.z; ab[j] += hv[3] * wj.w;
          }
        }
      }
      if (doAB) {
#pragma unroll
        for (int j = 0; j < 8; ++j) ab[j] = wsum(ab[j]);
        if (lane == 0) {
          *(float4*)(AB + (size_t)r * 8) = make_float4(ab[0], ab[1], ab[2], ab[3]);
          *(float4*)(AB + (size_t)r * 8 + 4) = make_float4(ab[4], ab[5], ab[6], ab[7]);
        }
      }
    }
  }
}

DI void rg_task(const Params& P, int l, int chunk, int n, int mode, char* smem) {
  float* xc_f = (float*)smem;
  bfu* xc_b = (bfu*)(xc_f + 64 * 65);
  float* a_s = (float*)(xc_b + 64 * 72);
  float* in_s = a_s + 4096;
  float* segP = in_s + 4096;
  float* segH = segP + 512;
  float* car = segH + 512;
  float* part = car + 64;
  const int tid = otid(), lane = tid & 63, wid = tid >> 6;
  bfu* PJ = (bfu*)(P.ws + WS_PROJ);
  const int tok0 = chunk * 64;
  const bool isS = chunk >= 256;
  const int c = tid & 63, tq = tid >> 6, cc = n * 64 + c;
  const bfu* RGW = (const bfu*)(P.ws + WS_RGW) + (size_t)n * 8192;
  bf16x8 wbr[4], wbi[4];
#pragma unroll
  for (int ks = 0; ks < 4; ++ks) {
    wbr[ks] = *(const bf16x8*)(RGW + ((wid & 1) * 32 + (lane & 31)) * 64 + ks * 16 + (lane >> 5) * 8);
    wbi[ks] = *(const bf16x8*)(RGW + (64 + (wid & 1) * 32 + (lane & 31)) * 64 + ks * 16 + (lane >> 5) * 8);
  }
  const int cch0 = n * 64 + (wid & 1) * 32 + (lane & 31);
  const float ba = P.in[16][l * 512 + cch0], bx = P.in[18][l * 512 + cch0];
  const float sp = softplusf(-P.in[19][l * 512 + cch0]);
  float gt2[2][8];
  float2 rprev[8];
  float* RGSUM = (float*)(P.ws + WS_RGSUM);
  if (mode != 0) {
#pragma unroll
    for (int q = 0; q < 2; ++q)
#pragma unroll
      for (int tt = 0; tt < 8; ++tt) gt2[q][tt] = bf2f(PJ[(size_t)(tok0 + (tq + 4 * q) * 8 + tt) * NPJ + C_RGG + cc]);
    if (!isS) {
      const int ci = chunk & 31, cs = chunk & ~31;
#pragma unroll
      for (int i = 0; i < 8; ++i) {
        const int c2 = tq * 8 + i;
        rprev[i] = (c2 < ci) ? *(const float2*)(RGSUM + ((size_t)(cs + c2) * 512 + cc) * 2) : make_float2(1.f, 0.f);
      }
    }
  }
  {
    const float* cw = P.in[13] + l * 2048;
    const float w0 = cw[cc], w1 = cw[512 + cc], w2 = cw[1024 + cc], w3 = cw[1536 + cc], cb = P.in[14][l * 512 + cc];
    if (!isS) {
      bfu* xs = (bfu*)a_s;
      const bool first = (chunk & 31) == 0;
#pragma unroll
      for (int j = 0; j < 3; ++j) {
        const int idx = tid + 256 * j;
        if (idx < 67 * 8) {
          const int row = idx >> 3, ch = idx & 7;
          u32x4 v = {0u, 0u, 0u, 0u};
          if (!(first && row < 3)) v = *(const u32x4*)(PJ + (size_t)(tok0 - 3 + row) * NPJ + C_RGX + n * 64 + ch * 8);
          *(u32x4*)(xs + row * 64 + ch * 8) = v;
        }
      }
      __syncthreads();
#pragma unroll 4
      for (int i = 0; i < 16; ++i) {
        const int t = tq + 4 * i;
        const float acc = cb + w0 * bf2f(xs[t * 64 + c]) + w1 * bf2f(xs[(t + 1) * 64 + c]) + w2 * bf2f(xs[(t + 2) * 64 + c]) + w3 * bf2f(xs[(t + 3) * 64 + c]);
        xc_f[t * 65 + c] = acc;
        xc_b[t * 72 + c] = f2bf(acc);
      }
    } else {
#pragma unroll 4
      for (int i = 0; i < 16; ++i) {
        const int t = tq + 4 * i, tok = tok0 + t, tl = tok & 7;
        float xk[4];
#pragma unroll
        for (int k = 0; k < 4; ++k) {
          const int j = tl + k - 3;
          if (j >= 0) xk[k] = bf2f(PJ[(size_t)(tok + k - 3) * NPJ + C_RGX + cc]);
          else xk[k] = P.in[2][((size_t)(l * 128 + ((tok - TP) >> 3)) * 3 + (tl + k)) * 512 + cc];
        }
        const float acc = cb + w0 * xk[0] + w1 * xk[1] + w2 * xk[2] + w3 * xk[3];
        xc_f[t * 65 + c] = acc;
        xc_b[t * 72 + c] = f2bf(acc);
      }
    }
  }
  __syncthreads();
  {
    const int mt = wid >> 1, ntl = wid & 1;
    f32x16 R, I;
#pragma unroll
    for (int r = 0; r < 16; ++r) { R[r] = 0.f; I[r] = 0.f; }
#pragma unroll
    for (int ks = 0; ks < 4; ++ks) {
      const bf16x8 a = *(const bf16x8*)(xc_b + (mt * 32 + (lane & 31)) * 72 + ks * 16 + (lane >> 5) * 8);
      R = MFMA32(a, wbr[ks], R);
      I = MFMA32(a, wbi[ks], I);
    }
    const int ch = ntl * 32 + (lane & 31);
#pragma unroll
    for (int r = 0; r < 16; ++r) {
      const int t = mt * 32 + rowmap(r, lane);
      const float rr = sigm(R[r] + ba), ig = sigm(I[r] + bx);
      const float la = -8.f * rr * sp;
      const float a = __expf(la);
      const float inp = sqrtf(fmaxf(-expm1f(2.f * la), 0.f)) * ig * xc_f[t * 65 + ch];
      a_s[t * 64 + ch] = a;
      in_s[t * 64 + ch] = inp;
    }
  }
  __syncthreads();
#pragma unroll
  for (int q = 0; q < 2; ++q) {
    const int sg = tq + 4 * q;
    float Pp = 1.f, Hh = 0.f;
#pragma unroll
    for (int tt = 0; tt < 8; ++tt) {
      const float a = a_s[(sg * 8 + tt) * 64 + c];
      Hh = a * Hh + in_s[(sg * 8 + tt) * 64 + c];
      Pp *= a;
    }
    segP[sg * 64 + c] = Pp; segH[sg * 64 + c] = Hh;
  }
  __syncthreads();
  if (mode == 0) {
    if (tid < 64) {
      float Pp = 1.f, Hh = 0.f;
#pragma unroll
      for (int sg = 0; sg < 8; ++sg) { Hh = segP[sg * 64 + c] * Hh + segH[sg * 64 + c]; Pp *= segP[sg * 64 + c]; }
      *(float2*)(RGSUM + ((size_t)chunk * 512 + cc) * 2) = make_float2(Pp, Hh);
    }
    return;
  }
  if (!isS) {
    const int ci = chunk & 31, cs = chunk & ~31;
    float Pp = 1.f, Hh = 0.f;
#pragma unroll
    for (int i = 0; i < 8; ++i) {
      const int c2 = tq * 8 + i;
      if (c2 < ci) {
        const float2 ph = rprev[i];
        Hh = ph.x * Hh + ph.y; Pp *= ph.x;
      }
    }
    part[(tq * 64 + c) * 2] = Pp; part[(tq * 64 + c) * 2 + 1] = Hh;
    __syncthreads();
    if (tid < 64) {
      float h = 0.f;
#pragma unroll
      for (int q2 = 0; q2 < 4; ++q2) h = part[(q2 * 64 + c) * 2] * h + part[(q2 * 64 + c) * 2 + 1];
      car[c] = h;
    }
    __syncthreads();
  }
#pragma unroll
  for (int q = 0; q < 2; ++q) {
    const int sg = tq + 4 * q;
    float h;
    const int sseq = (tok0 - TP) / 8 + sg;
    if (isS) h = P.in[3][(size_t)(l * 128 + sseq) * 512 + cc];
    else {
      h = car[c];
      for (int s2 = 0; s2 < sg; ++s2) h = segP[s2 * 64 + c] * h + segH[s2 * 64 + c];
    }
#pragma unroll
    for (int tt = 0; tt < 8; ++tt) {
      const int t = sg * 8 + tt;
      h = a_s[t * 64 + c] * h + in_s[t * 64 + c];
      PJ[(size_t)(tok0 + t) * NPJ + C_RGG + cc] = f2bf(h * geluf(gt2[q][tt]));
    }
    if (isS) P.out[O_SRH + (size_t)(l * 128 + sseq) * 512 + cc] = h;
    else if ((chunk & 31) == 31 && sg == 7) P.out[O_PRH + (size_t)(l * 8 + (chunk >> 5)) * 512 + cc] = h;
  }
  if (isS) {
    for (int idx = tid; idx < 8 * 3 * 64; idx += 256) {
      const int c3 = idx & 63, i = (idx >> 6) % 3, sg = idx / 192;
      const int sseq = (tok0 - TP) / 8 + sg;
      P.out[O_SRC + ((size_t)(l * 128 + sseq) * 3 + i) * 512 + n * 64 + c3] = bf2f(PJ[(size_t)(tok0 + sg * 8 + 5 + i) * NPJ + C_RGX + n * 64 + c3]);
    }
  } else if ((chunk & 31) == 31) {
    if (tid < 192) {
      const int c3 = tid & 63, i = tid >> 6;
      P.out[O_PRC + ((size_t)(l * 8 + (chunk >> 5)) * 3 + i) * 512 + n * 64 + c3] = bf2f(PJ[(size_t)(tok0 + 61 + i) * NPJ + C_RGX + n * 64 + c3]);
    }
  }
}

DI void s5_task(const Params& P, int l, int chunk, int g, int mode, char* smem) {
  float* bu_s = (float*)smem;
  bfu* ss_b = (bfu*)(bu_s + 8192);
  float* segS = (float*)(ss_b + 64 * 136);
  float* car = segS + 1024;
  float* part = car + 128;
  const int tid = otid(), lane = tid & 63, wid = tid >> 6;
  bfu* PJ = (bfu*)(P.ws + WS_PROJ);
  const int tok0 = chunk * 64;
  const bool isS = chunk >= 256;
  const int p = tid & 63, tq = tid >> 6;
  const float* LAMT = (const float*)(P.ws + WS_S5LAM);
  const float lr = LAMT[(g * 64 + p) * 2], li = LAMT[(g * 64 + p) * 2 + 1];
  float* S5SUM = (float*)(P.ws + WS_S5SUM);
  bf16x8 cfr[4];
  float2 sprev[8];
  float uu[4], st0[4];
  const int hh = lane & 15;
  const float dco = P.in[27][l * 512 + g * 16 + hh];
  if (mode != 0) {
    const bfu* CC = (const bfu*)(P.ws + WS_S5CC) + (size_t)g * 2048;
#pragma unroll
    for (int ks = 0; ks < 4; ++ks) cfr[ks] = *(const bf16x8*)(CC + (lane & 15) * 128 + ks * 32 + (lane >> 4) * 8);
#pragma unroll
    for (int r = 0; r < 4; ++r) uu[r] = bf2f(PJ[(size_t)(tok0 + wid * 16 + (lane >> 4) * 4 + r) * NPJ + C_S5U + g * 16 + hh]);
    if (!isS) {
      const int ci = chunk & 31, cs = chunk & ~31;
#pragma unroll
      for (int i = 0; i < 8; ++i) {
        const int c2 = tq * 8 + i;
        sprev[i] = (c2 < ci) ? *(const float2*)(S5SUM + (((size_t)(cs + c2) * 32 + g) * 64 + p) * 2) : make_float2(0.f, 0.f);
      }
    } else {
#pragma unroll
      for (int q = 0; q < 2; ++q) {
        const size_t si0 = ((size_t)(l * 128 + (tok0 - TP) / 8 + tq + 4 * q) * 32 + g) * 64 + p;
        st0[2 * q] = P.in[4][si0]; st0[2 * q + 1] = P.in[5][si0];
      }
    }
  }
  {
    const bfu* BB = (const bfu*)(P.ws + WS_S5BB) + (size_t)g * 2048;
    const bf16x8 b = *(const bf16x8*)(BB + (wid * 32 + (lane & 31)) * 16 + (lane >> 5) * 8);
#pragma unroll
    for (int mt = 0; mt < 2; ++mt) {
      const bf16x8 a = *(const bf16x8*)(PJ + (size_t)(tok0 + mt * 32 + (lane & 31)) * NPJ + C_S5U + g * 16 + (lane >> 5) * 8);
      f32x16 d;
#pragma unroll
      for (int r = 0; r < 16; ++r) d[r] = 0.f;
      d = MFMA32(a, b, d);
#pragma unroll
      for (int r = 0; r < 16; ++r) bu_s[(mt * 32 + rowmap(r, lane)) * 128 + wid * 32 + (lane & 31)] = d[r];
    }
  }
  __syncthreads();
#pragma unroll
  for (int q = 0; q < 2; ++q) {
    const int sg = tq + 4 * q;
    float sr = 0.f, si = 0.f;
#pragma unroll
    for (int tt = 0; tt < 8; ++tt) {
      const int t = sg * 8 + tt;
      const float nr = lr * sr - li * si + bu_s[t * 128 + p];
      const float ni = lr * si + li * sr + bu_s[t * 128 + 64 + p];
      sr = nr; si = ni;
    }
    segS[(sg * 64 + p) * 2] = sr; segS[(sg * 64 + p) * 2 + 1] = si;
  }
  __syncthreads();
  float l8r = lr, l8i = li;
#pragma unroll
  for (int k = 0; k < 3; ++k) { const float nr = l8r * l8r - l8i * l8i, ni = 2.f * l8r * l8i; l8r = nr; l8i = ni; }
  if (mode == 0) {
    if (tid < 64) {
      float sr = 0.f, si = 0.f;
#pragma unroll
      for (int sg = 0; sg < 8; ++sg) {
        const float nr = l8r * sr - l8i * si + segS[(sg * 64 + p) * 2];
        const float ni = l8r * si + l8i * sr + segS[(sg * 64 + p) * 2 + 1];
        sr = nr; si = ni;
      }
      *(float2*)(S5SUM + (((size_t)chunk * 32 + g) * 64 + p) * 2) = make_float2(sr, si);
    }
    return;
  }
  if (!isS) {
    float l64r = l8r, l64i = l8i;
#pragma unroll
    for (int k = 0; k < 3; ++k) { const float nr = l64r * l64r - l64i * l64i, ni = 2.f * l64r * l64i; l64r = nr; l64i = ni; }
    const int ci = chunk & 31, cs = chunk & ~31;
    float ar = 0.f, ai = 0.f;
#pragma unroll
    for (int i = 0; i < 8; ++i) {
      const int c2 = tq * 8 + i;
      if (c2 < ci) {
        const float2 sv = sprev[i];
        const float nr = l64r * ar - l64i * ai + sv.x, ni = l64r * ai + l64i * ar + sv.y;
        ar = nr; ai = ni;
      }
    }
    part[(tq * 64 + p) * 2] = ar; part[(tq * 64 + p) * 2 + 1] = ai;
    __syncthreads();
    if (tid < 64) {
      float cr = 0.f, cim = 0.f;
      for (int q2 = 0; q2 < 4; ++q2) {
        const int cnt = min(max(ci - q2 * 8, 0), 8);
        for (int k = 0; k < cnt; ++k) { const float nr = l64r * cr - l64i * cim, ni = l64r * cim + l64i * cr; cr = nr; cim = ni; }
        cr += part[(q2 * 64 + p) * 2]; cim += part[(q2 * 64 + p) * 2 + 1];
      }
      car[p * 2] = cr; car[p * 2 + 1] = cim;
    }
    __syncthreads();
  }
#pragma unroll
  for (int q = 0; q < 2; ++q) {
    const int sg = tq + 4 * q;
    const int sseq = (tok0 - TP) / 8 + sg;
    float sr, si;
    if (isS) {
      sr = st0[2 * q]; si = st0[2 * q + 1];
    } else {
      sr = car[p * 2]; si = car[p * 2 + 1];
      for (int s2 = 0; s2 < sg; ++s2) {
        const float nr = l8r * sr - l8i * si + segS[(s2 * 64 + p) * 2];
        const float ni = l8r * si + l8i * sr + segS[(s2 * 64 + p) * 2 + 1];
        sr = nr; si = ni;
      }
    }
#pragma unroll
    for (int tt = 0; tt < 8; ++tt) {
      const int t = sg * 8 + tt;
      const float nr = lr * sr - li * si + bu_s[t * 128 + p];
      const float ni = lr * si + li * sr + bu_s[t * 128 + 64 + p];
      sr = nr; si = ni;
      ss_b[t * 136 + p] = f2bf(sr);
      ss_b[t * 136 + 64 + p] = f2bf(si);
    }
    if (isS) {
      const size_t so = ((size_t)(l * 128 + sseq) * 32 + g) * 64 + p;
      P.out[O_SSR + so] = sr; P.out[O_SSI + so] = si;
    } else if ((chunk & 31) == 31 && sg == 7) {
      const size_t so = ((size_t)(l * 8 + (chunk >> 5)) * 32 + g) * 64 + p;
      P.out[O_PSR + so] = sr; P.out[O_PSI + so] = si;
    }
  }
  __syncthreads();
  {
    f32x4 acc = {0.f, 0.f, 0.f, 0.f};
#pragma unroll
    for (int ks = 0; ks < 4; ++ks) {
      const bf16x8 a = *(const bf16x8*)(ss_b + (wid * 16 + (lane & 15)) * 136 + ks * 32 + (lane >> 4) * 8);
      acc = MFMA16(a, cfr[ks], acc);
    }
    const int h = hh;
#pragma unroll
    for (int r = 0; r < 4; ++r) {
      const int t = wid * 16 + (lane >> 4) * 4 + r;
      PJ[(size_t)(tok0 + t) * NPJ + C_S5U + g * 16 + h] = f2bf(geluf(acc[r] + dco * uu[r]));
    }
  }
}

DI void gdn_conv_col(const Params& P, int l, int chunk, int ch, float (&v)[64]) {
  const bfu* PJ = (const bfu*)(P.ws + WS_PROJ);
  const int tok0 = chunk * 64;
  const bool isS = chunk >= 256;
  const float* cw = P.in[32] + l * 4 * 1536;
  const float w0 = cw[ch], w1 = cw[1536 + ch], w2 = cw[2 * 1536 + ch], w3 = cw[3 * 1536 + ch];
  float x3 = 0.f, x2 = 0.f, x1 = 0.f;
  if (!isS && (chunk & 31) != 0) {
    x3 = bf2f(PJ[(size_t)(tok0 - 3) * NPJ + C_QKV + ch]);
    x2 = bf2f(PJ[(size_t)(tok0 - 2) * NPJ + C_QKV + ch]);
    x1 = bf2f(PJ[(size_t)(tok0 - 1) * NPJ + C_QKV + ch]);
  }
#pragma unroll
  for (int sg = 0; sg < 8; ++sg) {
    if (isS) {
      const float* st = P.in[6] + ((size_t)(l * 128 + (chunk - 256) * 8 + sg) * 3) * 1536 + ch;
      x3 = st[0]; x2 = st[1536]; x1 = st[2 * 1536];
    }
#pragma unroll
    for (int tt = 0; tt < 8; ++tt) {
      const int t = sg * 8 + tt;
      const float x = bf2f(PJ[(size_t)(tok0 + t) * NPJ + C_QKV + ch]);
      v[t] = siluf(w0 * x3 + w1 * x2 + w2 * x1 + w3 * x);
      x3 = x2; x2 = x1; x1 = x;
    }
  }
}

DI void gdn1_task(const Params& P, int l, int chunk, int head, char* smem) {
  bfu* qn_b = (bfu*)smem;
  bfu* kn_b = qn_b + 64 * 136;
  float* L_s = (float*)(kn_b + 64 * 136);
  float* rq = L_s + 4096;
  float* rk = rq + 64;
  float* sbeta = rk + 64;
  float* sg_ = sbeta + 64;
  float* gcs = sg_ + 64;
  float* eg = gcs + 64;
  float* gl = eg + 64;
  const int tid = otid(), lane = tid & 63, wid = tid >> 6;
  const bfu* PJ = (const bfu*)(P.ws + WS_PROJ);
  const int tok0 = chunk * 64;
  const bool isS = chunk >= 256;
  float v[64];
  gdn_conv_col(P, l, chunk, (tid < 128) ? (head * 128 + tid) : (512 + head * 128 + (tid - 128)), v);
  {
    bfu* dstb = (tid < 128) ? (qn_b + tid) : (kn_b + (tid - 128));
#pragma unroll
    for (int t = 0; t < 64; ++t) dstb[t * 136] = f2bf(v[t]);
  }
  if (tid < 64) {
    const float* AB = (const float*)(P.ws + WS_AB) + (size_t)(tok0 + tid) * 8;
    sbeta[tid] = sigm(AB[4 + head]);
    sg_[tid] = -__expf(P.in[33][l * 4 + head]) * softplusf(AB[head] + P.in[34][l * 4 + head]);
  }
  __syncthreads();
  if (tid < 128) {
    const bfu* rowp = (tid < 64 ? qn_b : kn_b) + (tid & 63) * 136;
    float s = 0.f;
    for (int d = 0; d < 128; ++d) { const float x = bf2f(rowp[d]); s += x * x; }
    if (tid < 64) rq[tid] = rsqrtf(s + 1e-6f) * 0.08838834764831845f;
    else rk[tid - 64] = rsqrtf(s + 1e-6f);
  } else if (tid < 136) {
    const int sg = tid - 128;
    if (isS) {
      float a = 0.f;
      for (int tt = 0; tt < 8; ++tt) { a += sg_[sg * 8 + tt]; gcs[sg * 8 + tt] = a; eg[sg * 8 + tt] = __expf(a); }
      gl[sg] = a;
    } else if (sg == 0) {
      float a = 0.f;
      for (int t = 0; t < 64; ++t) { a += sg_[t]; gcs[t] = a; eg[t] = __expf(a); }
      for (int s2 = 0; s2 < 8; ++s2) gl[s2] = a;
    }
  }
  __syncthreads();
  if (tid < 128) {
    bfu* QG = (bfu*)(P.ws + WS_GQG) + (size_t)tok0 * 512 + head * 128 + tid;
#pragma unroll
    for (int t = 0; t < 64; ++t) QG[(size_t)t * 512] = f2bf(v[t] * rq[t] * eg[t]);
    gdn_conv_col(P, l, chunk, 1024 + head * 128 + tid, v);
  } else {
    bfu* KD = (bfu*)(P.ws + WS_GKD) + (size_t)(chunk * 4 + head) * 8192 + (size_t)(tid - 128) * 64;
#pragma unroll
    for (int t8 = 0; t8 < 8; ++t8) {
      float kd[8];
#pragma unroll
      for (int e = 0; e < 8; ++e) {
        const int t = t8 * 8 + e;
        kd[e] = v[t] * rk[t] * __expf(gl[isS ? t8 : 0] - gcs[t]);
      }
      uint4 pk;
      pk.x = pk2(kd[0], kd[1]); pk.y = pk2(kd[2], kd[3]); pk.z = pk2(kd[4], kd[5]); pk.w = pk2(kd[6], kd[7]);
      *(uint4*)(KD + t8 * 8) = pk;
    }
  }
  {
    bfu* QK = (bfu*)(P.ws + WS_GQK) + (size_t)(chunk * 4 + head) * 4096;
    const int mt = wid >> 1, nt = wid & 1;
    f32x16 KK, QQ;
#pragma unroll
    for (int r = 0; r < 16; ++r) { KK[r] = 0.f; QQ[r] = 0.f; }
#pragma unroll
    for (int ks = 0; ks < 8; ++ks) {
      const bf16x8 ak = *(const bf16x8*)(kn_b + (mt * 32 + (lane & 31)) * 136 + ks * 16 + (lane >> 5) * 8);
      const bf16x8 aq = *(const bf16x8*)(qn_b + (mt * 32 + (lane & 31)) * 136 + ks * 16 + (lane >> 5) * 8);
      const bf16x8 bk = *(const bf16x8*)(kn_b + (nt * 32 + (lane & 31)) * 136 + ks * 16 + (lane >> 5) * 8);
      KK = MFMA32(ak, bk, KK);
      QQ = MFMA32(aq, bk, QQ);
    }
    const int j = nt * 32 + (lane & 31);
    const float gcj = gcs[j], rkj = rk[j];
#pragma unroll
    for (int r = 0; r < 16; ++r) {
      const int i = mt * 32 + rowmap(r, lane);
      const bool ok = (i >= j) && (!isS || ((i >> 3) == (j >> 3)));
      const float dec = ok ? __expf(gcs[i] - gcj) : 0.f;
      L_s[i * 64 + j] = (i > j) ? sbeta[i] * (rk[i] * rkj * KK[r]) * dec : 0.f;
      QK[i * 64 + j] = f2bf(rq[i] * rkj * QQ[r] * dec);
    }
  }
  __syncthreads();
  {
    if (tid < 128) {
#pragma unroll
      for (int t = 0; t < 64; ++t) v[t] *= sbeta[t];
    } else {
#pragma unroll
      for (int t = 0; t < 64; ++t) v[t] *= rk[t] * sbeta[t] * eg[t];
    }
#pragma unroll
    for (int i = 1; i < 64; ++i) {
      float s = v[i];
#pragma unroll
      for (int j4 = 0; j4 <= (i - 1) / 4; ++j4) {
        const float4 lv = *(const float4*)(L_s + i * 64 + j4 * 4);
        s -= lv.x * v[j4 * 4];
        if (j4 * 4 + 1 < i) s -= lv.y * v[j4 * 4 + 1];
        if (j4 * 4 + 2 < i) s -= lv.z * v[j4 * 4 + 2];
        if (j4 * 4 + 3 < i) s -= lv.w * v[j4 * 4 + 3];
      }
      v[i] = s;
    }
    bfu* dst = (bfu*)(P.ws + (tid < 128 ? WS_GU : WS_GW)) + (size_t)tok0 * 512 + head * 128 + (tid & 127);
#pragma unroll
    for (int t = 0; t < 64; ++t) dst[(size_t)t * 512] = f2bf(v[t]);
  }
  if (tid < 8) ((float*)(P.ws + WS_GDEC))[(chunk * 4 + head) * 32 + tid] = __expf(gl[tid]);
  if (isS) {
    for (int idx = tid; idx < 8 * 3 * 384; idx += 256) {
      const int cq = idx % 384, i = (idx / 384) % 3, sg = idx / 1152;
      const int ch = (cq >> 7) * 512 + head * 128 + (cq & 127);
      const int sseq = (chunk - 256) * 8 + sg;
      P.out[O_SGC + ((size_t)(l * 128 + sseq) * 3 + i) * 1536 + ch] = bf2f(PJ[(size_t)(tok0 + sg * 8 + 5 + i) * NPJ + C_QKV + ch]);
    }
  } else if ((chunk & 31) == 31) {
    for (int idx = tid; idx < 3 * 384; idx += 256) {
      const int cq = idx % 384, i = idx / 384;
      const int ch = (cq >> 7) * 512 + head * 128 + (cq & 127);
      P.out[O_PGC + ((size_t)(l * 8 + (chunk >> 5)) * 3 + i) * 1536 + ch] = bf2f(PJ[(size_t)(tok0 + 61 + i) * NPJ + C_QKV + ch]);
    }
  }
}

DI void gdn2_task(const Params& P, int l, int useq, int head, int dvs, char* smem) {
  bfu* Sb = (bfu*)smem;
  bfu* Vn = Sb + 32 * 136;
  const int tid = otid(), lane = tid & 63, w = tid >> 6;
  const bool isS = useq >= 8;
  const int sseq = useq - 8;
  const int nch = isS ? 1 : 32;
  const int chunk0 = isS ? (256 + (sseq >> 3)) : useq * 32;
  const int vseg = isS ? (sseq & 7) : -1;
  const bfu* GW = (const bfu*)(P.ws + WS_GW);
  const bfu* GQ = (const bfu*)(P.ws + WS_GQG);
  const bfu* GU = (const bfu*)(P.ws + WS_GU);
  bfu* PJO = (bfu*)(P.ws + WS_PROJ);
  const bfu* GKD = (const bfu*)(P.ws + WS_GKD);
  const bfu* GQK = (const bfu*)(P.ws + WS_GQK);
  const float* GDEC = (const float*)(P.ws + WS_GDEC);
  const int dv = dvs * 32 + (lane & 31);
  f32x16 S;
  if (isS) {
    const float* s0 = P.in[7] + ((size_t)((l * 128 + sseq) * 4 + head) * 128) * 128 + dv;
#pragma unroll
    for (int r = 0; r < 16; ++r) S[r] = s0[(size_t)(32 * w + rowmap(r, lane)) * 128];
  } else {
#pragma unroll
    for (int r = 0; r < 16; ++r) S[r] = 0.f;
  }
  const bf16x8 zero8 = {0, 0, 0, 0, 0, 0, 0, 0};
  for (int ci = 0; ci < nch; ++ci) {
    const int chunk = chunk0 + ci, tok0 = chunk * 64;
    const int mt = w & 1;
    const int row = mt * 32 + (lane & 31);
    const bool rvalid = !isS || ((row >> 3) == vseg);
    bf16x8 aA[8], aQ[4], aK[4];
    float uu[16];
    {
      const bfu* Ab = (w < 2 ? GW : GQ) + (size_t)(tok0 + row) * 512 + head * 128 + (lane >> 5) * 8;
#pragma unroll
      for (int ks = 0; ks < 8; ++ks) aA[ks] = rvalid ? *(const bf16x8*)(Ab + ks * 16) : zero8;
      const bfu* Kb = GKD + ((size_t)(chunk * 4 + head) * 128 + 32 * w + (lane & 31)) * 64 + (lane >> 5) * 8;
#pragma unroll
      for (int ks = 0; ks < 4; ++ks) {
        const bool gv = !isS || ((ks * 2 + (lane >> 5)) == vseg);
        aK[ks] = gv ? *(const bf16x8*)(Kb + ks * 16) : zero8;
      }
      if (w >= 2) {
        const bfu* Qb = GQK + ((size_t)(chunk * 4 + head) * 64 + row) * 64 + (lane >> 5) * 8;
#pragma unroll
        for (int ks = 0; ks < 4; ++ks) aQ[ks] = rvalid ? *(const bf16x8*)(Qb + ks * 16) : zero8;
#pragma unroll
        for (int r = 0; r < 16; ++r) uu[r] = 0.f;
      } else {
#pragma unroll
        for (int ks = 0; ks < 4; ++ks) aQ[ks] = zero8;
#pragma unroll
        for (int r = 0; r < 16; ++r) {
          const int t = mt * 32 + rowmap(r, lane);
          const bool tv = !isS || ((t >> 3) == vseg);
          uu[r] = tv ? bf2f(GU[(size_t)(tok0 + t) * 512 + head * 128 + dv]) : 0.f;
        }
      }
    }
    const float gdec = GDEC[(chunk * 4 + head) * 32 + (isS ? vseg : 0)];
    __syncthreads();
#pragma unroll
    for (int g4 = 0; g4 < 4; ++g4) {
      uint2 pk;
      pk.x = pk2(S[4 * g4], S[4 * g4 + 1]); pk.y = pk2(S[4 * g4 + 2], S[4 * g4 + 3]);
      *(uint2*)(Sb + (lane & 31) * 136 + 32 * w + 8 * g4 + 4 * (lane >> 5)) = pk;
    }
    __syncthreads();
    f32x16 acc;
#pragma unroll
    for (int r = 0; r < 16; ++r) acc[r] = 0.f;
#pragma unroll
    for (int ks = 0; ks < 8; ++ks) {
      const bf16x8 b8 = *(const bf16x8*)(Sb + (lane & 31) * 136 + ks * 16 + (lane >> 5) * 8);
      acc = MFMA32(aA[ks], b8, acc);
    }
    if (w < 2) {
#pragma unroll
      for (int g4 = 0; g4 < 4; ++g4) {
        uint2 pk;
        pk.x = pk2(uu[4 * g4] - acc[4 * g4], uu[4 * g4 + 1] - acc[4 * g4 + 1]);
        pk.y = pk2(uu[4 * g4 + 2] - acc[4 * g4 + 2], uu[4 * g4 + 3] - acc[4 * g4 + 3]);
        *(uint2*)(Vn + (lane & 31) * 72 + mt * 32 + 8 * g4 + 4 * (lane >> 5)) = pk;
      }
    }
    __syncthreads();
    if (w >= 2) {
#pragma unroll
      for (int ks = 0; ks < 4; ++ks) {
        const bf16x8 b8 = *(const bf16x8*)(Vn + (lane & 31) * 72 + ks * 16 + (lane >> 5) * 8);
        acc = MFMA32(aQ[ks], b8, acc);
      }
#pragma unroll
      for (int r = 0; r < 16; ++r) {
        const int t = mt * 32 + rowmap(r, lane);
        const bool tv = !isS || ((t >> 3) == vseg);
        if (tv) PJO[(size_t)(tok0 + t) * NPJ + C_QKV + (head * 4 + dvs) * 64 + (lane & 31)] = f2bf(acc[r]);
      }
    }
    {
#pragma unroll
      for (int r = 0; r < 16; ++r) S[r] *= gdec;
#pragma unroll
      for (int ks = 0; ks < 4; ++ks) {
        const bf16x8 b8 = *(const bf16x8*)(Vn + (lane & 31) * 72 + ks * 16 + (lane >> 5) * 8);
        S = MFMA32(aK[ks], b8, S);
      }
    }
  }
  float* so = P.out + (isS ? (O_SGS + ((size_t)((l * 128 + sseq) * 4 + head) * 128) * 128)
                           : (O_PGS + ((size_t)((l * 8 + useq) * 4 + head) * 128) * 128)) + dv;
#pragma unroll
  for (int r = 0; r < 16; ++r) so[(size_t)(32 * w + rowmap(r, lane)) * 128] = S[r];
}

DI void gdn3_pass(const Params& P, int l) {
  const int tid_ = otid(), lane = tid_ & 63, wid = tid_ >> 6;
  const int nw = gridDim.x * 4, gw = blockIdx.x * 4 + wid;
  const bfu* GU = (const bfu*)(P.ws + WS_GU);
  bfu* PJ = (bfu*)(P.ws + WS_PROJ);
  const float* nwt = P.in[35] + l * 128 + (lane & 15) * 8;
  for (int r = gw; r < T_ALL; r += nw) {
    const uint4 ov = *(const uint4*)(PJ + (size_t)r * NPJ + C_QKV + (lane >> 2) * 64 + (lane & 3) * 8);
    const uint4 zv = *(const uint4*)(PJ + (size_t)r * NPJ + C_Z + lane * 8);
    float o[8], z[8];
    const unsigned ow[4] = {ov.x, ov.y, ov.z, ov.w}, zw[4] = {zv.x, zv.y, zv.z, zv.w};
    float ss = 0.f;
#pragma unroll
    for (int e = 0; e < 4; ++e) {
      o[2 * e] = __uint_as_float(ow[e] << 16); o[2 * e + 1] = __uint_as_float(ow[e] & 0xffff0000u);
      z[2 * e] = __uint_as_float(zw[e] << 16); z[2 * e + 1] = __uint_as_float(zw[e] & 0xffff0000u);
      ss += o[2 * e] * o[2 * e] + o[2 * e + 1] * o[2 * e + 1];
    }
    ss += __shfl_xor(ss, 1, 64); ss += __shfl_xor(ss, 2, 64); ss += __shfl_xor(ss, 4, 64); ss += __shfl_xor(ss, 8, 64);
    const float rn = rsqrtf(ss * (1.f / 128.f) + 1e-6f);
    float res[8];
#pragma unroll
    for (int e = 0; e < 8; ++e) res[e] = o[e] * rn * nwt[e] * siluf(z[e]);
    uint4 pk;
    pk.x = pk2(res[0], res[1]); pk.y = pk2(res[2], res[3]); pk.z = pk2(res[4], res[5]); pk.w = pk2(res[6], res[7]);
    *(uint4*)(PJ + (size_t)r * NPJ + C_Z + lane * 8) = pk;
  }
}

DI void phase_mix1a(const Params& P, int l, char* smem) {
  for (int t = blockIdx.x; t < 1088; t += gridDim.x) {
    __syncthreads();
    gdn1_task(P, l, t >> 2, t & 3, smem);
  }
}
DI void phase_mix1b(const Params& P, int l, char* smem) {
  const int NT = 2048 + 8192;
  for (int t = blockIdx.x; t < NT; t += gridDim.x) {
    __syncthreads();
    if (t < 2048) rg_task(P, l, t >> 3, t & 7, 0, smem);
    else { const int r = t - 2048; s5_task(P, l, r >> 5, r & 31, 0, smem); }
  }
}

DI void phase_mix2(const Params& P, int l, char* smem) {
  const int G = gridDim.x;
  for (int t = blockIdx.x; t < 128; t += G) {
    __syncthreads();
    gdn2_task(P, l, t >> 4, (t >> 2) & 3, t & 3, smem);
  }
  unsigned* ctr = (unsigned*)(P.ws + WS_BAR) + XB_WORDS + 64 * (1 + l);
  volatile int* nxt = (volatile int*)(smem + LDS_BYTES - 16);
  const int NR = 2176 + 2176 + 2048;
  for (;;) {
    __syncthreads();
    if (threadIdx.x == 0) *nxt = (int)__hip_atomic_fetch_add(ctr, 1u, __ATOMIC_RELAXED, __HIP_MEMORY_SCOPE_AGENT);
    __syncthreads();
    const int r = *nxt;
    if (r >= NR) break;
    __syncthreads();
    if (r < 2176) {
#pragma unroll 1
      for (int gg = 0; gg < 4; ++gg) { if (gg) __syncthreads(); s5_task(P, l, r >> 3, (r & 7) * 4 + gg, 1, smem); }
    } else if (r < 4352) { const int q = r - 2176; rg_task(P, l, q >> 3, q & 7, 1, smem); }
    else { const int q = r - 4352; gdn2_task(P, l, 8 + (q >> 4), (q >> 2) & 3, q & 3, smem); }
  }
}

__global__ void __launch_bounds__(256, 2) mega_kernel(Params P) {
  extern __shared__ __attribute__((aligned(16))) char smem[];
  cg::grid_group grid = cg::this_grid();
  char* ws = P.ws;
  if (P.out == nullptr) grid.sync();
  GBar gb;
  gbar_init(gb, (unsigned*)(ws + WS_BAR));
  prep_layer(P, 0, smem);
  norm_pass(P, 0, 0, smem);
  gsync(gb);
#pragma unroll 1
  for (int l = 0; l < 2; ++l) {
    gemm_plain((const bfu*)(ws + WS_H), 1024, (const bfu*)(ws + WS_WIN), 1024, 1024, 3584, (bfu*)(ws + WS_PROJ), NPJ, smem);
    gsync(gb);
    phase_mix1b(P, l, smem);
    gsync(gb);
    phase_mix1a(P, l, smem);
    gsync(gb);
    phase_mix2(P, l, smem);
    gsync(gb);
    gemm_glu(P, l, smem);
    gdn3_pass(P, l);
    gsync(gb);
    gemm_merge(P, smem);
    gsync(gb);
    gemm_plain((const bfu*)(ws + WS_MIXED), 1024, (const bfu*)(ws + WS_WOUT), 1024, 1024, 1024, (bfu*)(ws + WS_MO), 1024, smem);
    gsync(gb);
    norm_pass(P, l, 1, smem);
    gsync(gb);
    gemm_ffn1(P, smem);
    gsync(gb);
    gemm_plain((const bfu*)(ws + WS_ACT), 2816, (const bfu*)(ws + WS_WDN), 2816, 2816, 1024, (bfu*)(ws + WS_FO), 1024, smem);
    gsync(gb);
    norm_pass(P, l, 2, smem);
    if (l == 0) prep_layer(P, 1, smem);
    gsync(gb);
  }
}

extern "C" void kernel_launch(void* const* d_in, const int* in_sizes, int n_in, void* d_out, int out_size, void* d_ws, size_t ws_size,
                              hipStream_t stream) {
  static int grid_blocks = 0;
  if (!grid_blocks) {
    int dev = 0, cus = 0, per_cu = 0;
    hipGetDevice(&dev);
    hipDeviceGetAttribute(&cus, hipDeviceAttributeMultiprocessorCount, dev);
    hipFuncSetAttribute((const void*)mega_kernel, hipFuncAttributeMaxDynamicSharedMemorySize, LDS_BYTES);
    hipOccupancyMaxActiveBlocksPerMultiprocessor(&per_cu, mega_kernel, 256, LDS_BYTES);
    if (per_cu > 2) per_cu = 2;
    if (per_cu < 1) per_cu = 1;
    grid_blocks = cus * per_cu;
    grid_blocks &= ~7;
  }
  if (ws_size < WS_END) { fprintf(stderr, "workspace too small: %zu < %zu\n", ws_size, (size_t)WS_END); return; }
  Params p{};
  for (int i = 0; i < 41; ++i) p.in[i] = (const float*)d_in[i];
  p.out = (float*)d_out;
  p.ws = (char*)d_ws;
  hipMemsetAsync((char*)d_ws + WS_BAR, 0, 16384, stream);
  void* args[] = {&p};
  hipError_t e = hipLaunchCooperativeKernel((const void*)mega_kernel, dim3(grid_blocks), dim3(256), args, LDS_BYTES, stream);
  if (e != hipSuccess) fprintf(stderr, "cooperative launch failed: %s (grid %d)\n", hipGetErrorString(e), grid_blocks);
}
```

```cpp
#include <hip/hip_runtime.h>
#include <hip/hip_cooperative_groups.h>
#include <cstdio>
namespace cg = cooperative_groups;

typedef unsigned short bfu;
using bf16x8 = __attribute__((ext_vector_type(8))) short;
using f32x16 = __attribute__((ext_vector_type(16))) float;
using f32x4  = __attribute__((ext_vector_type(4))) float;
using u32x4  = __attribute__((ext_vector_type(4))) unsigned;
#define DI __device__ __forceinline__
#define MFMA32(a, b, c) __builtin_amdgcn_mfma_f32_32x32x16_bf16((a), (b), (c), 0, 0, 0)
#define MFMA16(a, b, c) __builtin_amdgcn_mfma_f32_16x16x32_bf16((a), (b), (c), 0, 0, 0)

constexpr int T_ALL = 17408, TP = 16384, NPJ = 3584;
constexpr int C_RGX = 0, C_RGG = 512, C_S5U = 1024, C_QKV = 1536, C_Z = 3072;
constexpr int LDS_BYTES = 65536;

constexpr size_t O_PRC = 17825792, O_PRH = O_PRC + 24576, O_PSR = O_PRH + 8192, O_PSI = O_PSR + 32768,
                 O_PGC = O_PSI + 32768, O_PGS = O_PGC + 73728, O_SRC = O_PGS + 1048576, O_SRH = O_SRC + 393216,
                 O_SSR = O_SRH + 131072, O_SSI = O_SSR + 524288, O_SGC = O_SSI + 524288, O_SGS = O_SGC + 1179648;

constexpr size_t WS_WIN = 0;
constexpr size_t WS_RGO = WS_WIN + (size_t)6656 * 1024 * 2;
constexpr size_t WS_S5O = WS_RGO + (size_t)1024 * 512 * 2;
constexpr size_t WS_GDO = WS_S5O + (size_t)1024 * 512 * 2;
constexpr size_t WS_GLU = WS_GDO + (size_t)1024 * 512 * 2;
constexpr size_t WS_WOUT = WS_GLU + (size_t)512 * 512 * 2;
constexpr size_t WS_WGU = WS_WOUT + (size_t)1024 * 1024 * 2;
constexpr size_t WS_WDN = WS_WGU + (size_t)5632 * 1024 * 2;
constexpr size_t WS_RGW = WS_WDN + (size_t)1024 * 2816 * 2;
constexpr size_t WS_S5BB = WS_RGW + (size_t)8 * 128 * 64 * 2;
constexpr size_t WS_S5CC = WS_S5BB + (size_t)65536 * 2;
constexpr size_t WS_S5LAM = WS_S5CC + (size_t)65536 * 2;
constexpr size_t WS_H = WS_S5LAM + (size_t)4096 * 4;
constexpr size_t WS_PROJ = WS_H + (size_t)T_ALL * 1024 * 2;
constexpr size_t WS_GQG = WS_PROJ + (size_t)T_ALL * NPJ * 2;
constexpr size_t WS_GU = WS_GQG + (size_t)T_ALL * 512 * 2;
constexpr size_t WS_GW = WS_GU + (size_t)T_ALL * 512 * 2;
constexpr size_t WS_GKD = WS_GW + (size_t)T_ALL * 512 * 2;
constexpr size_t WS_GQK = WS_GKD + (size_t)272 * 4 * 128 * 64 * 2;
constexpr size_t WS_AB = WS_GQK + (size_t)272 * 4 * 64 * 64 * 2;
constexpr size_t WS_RGSUM = WS_AB + (size_t)T_ALL * 8 * 4;
constexpr size_t WS_S5SUM = WS_RGSUM + (size_t)256 * 512 * 2 * 4;
constexpr size_t WS_GDEC = WS_S5SUM + (size_t)256 * 32 * 64 * 2 * 4;
constexpr size_t WS_BAR = WS_GDEC + (size_t)272 * 4 * 32 * 4;
constexpr size_t WS_END = WS_BAR + 16384;
constexpr size_t WS_MIXED = WS_GQG, WS_MO = WS_PROJ, WS_ACT = WS_PROJ, WS_FO = WS_GQG;

struct Params {
  const float* in[41];
  float* out;
  char* ws;
};

DI int otid() { int t = threadIdx.x; asm volatile("" : "+v"(t)); return t; }
DI bfu f2bf(float x) { unsigned u = __float_as_uint(x); u += 0x7fffu + ((u >> 16) & 1u); return (bfu)(u >> 16); }
DI float bf2f(bfu v) { return __uint_as_float(((unsigned)v) << 16); }
DI unsigned pk2(float a, float b) { return (unsigned)f2bf(a) | ((unsigned)f2bf(b) << 16); }
DI float sigm(float x) { return 1.f / (1.f + __expf(-x)); }
DI float siluf(float x) { return x * sigm(x); }
DI float geluf(float x) { float u = 0.7978845608028654f * (x + 0.044715f * x * x * x); float t = __expf(2.f * u); return 0.5f * x * (2.f - 2.f / (t + 1.f)); }
DI float softplusf(float x) { return fmaxf(x, 0.f) + log1pf(__expf(-fabsf(x))); }
DI float wsum(float v) { for (int o = 32; o > 0; o >>= 1) v += __shfl_xor(v, o, 64); return v; }
DI int rowmap(int reg, int lane) { return (reg & 3) + 8 * (reg >> 2) + 4 * (lane >> 5); }

template <int MT>
DI void gemm_tile(const bfu* __restrict__ A, int lda, const bfu* __restrict__ W, int ldw, int K, f32x16 (&acc)[MT][2], char* smem) {
  constexpr int BM = 64 * MT, LS = 72;
  bfu* As = (bfu*)smem;
  bfu* Ws = As + BM * LS;
  const int tid = otid(), lane = tid & 63, wid = tid >> 6, wm = wid >> 1, wn = wid & 1;
  const int lr = tid >> 3, lc = tid & 7;
  u32x4 ra[2 * MT], rw[4];
  const bfu* Ap = A + (size_t)lr * lda + lc * 8;
  const bfu* Wp = W + (size_t)lr * ldw + lc * 8;
#pragma unroll
  for (int i = 0; i < 2 * MT; ++i) ra[i] = *(const u32x4*)(Ap + (size_t)i * 32 * lda);
#pragma unroll
  for (int i = 0; i < 4; ++i) rw[i] = *(const u32x4*)(Wp + (size_t)i * 32 * ldw);
  const int nk = K >> 6;
  const int arow = wm * 32 * MT + (lane & 31), wrow = wn * 64 + (lane & 31), kof = (lane >> 5) * 8;
  for (int kt = 0; kt < nk; ++kt) {
    __syncthreads();
#pragma unroll
    for (int i = 0; i < 2 * MT; ++i) *(u32x4*)(As + (lr + 32 * i) * LS + lc * 8) = ra[i];
#pragma unroll
    for (int i = 0; i < 4; ++i) *(u32x4*)(Ws + (lr + 32 * i) * LS + lc * 8) = rw[i];
    if (kt + 1 < nk) {
      Ap += 64; Wp += 64;
#pragma unroll
      for (int i = 0; i < 2 * MT; ++i) ra[i] = *(const u32x4*)(Ap + (size_t)i * 32 * lda);
#pragma unroll
      for (int i = 0; i < 4; ++i) rw[i] = *(const u32x4*)(Wp + (size_t)i * 32 * ldw);
    }
    __syncthreads();
#pragma unroll
    for (int ks = 0; ks < 4; ++ks) {
      bf16x8 af[MT], wf[2];
#pragma unroll
      for (int mt = 0; mt < MT; ++mt) af[mt] = *(const bf16x8*)(As + (arow + mt * 32) * LS + ks * 16 + kof);
#pragma unroll
      for (int nt = 0; nt < 2; ++nt) wf[nt] = *(const bf16x8*)(Ws + (wrow + nt * 32) * LS + ks * 16 + kof);
#pragma unroll
      for (int mt = 0; mt < MT; ++mt)
#pragma unroll
        for (int nt = 0; nt < 2; ++nt) acc[mt][nt] = MFMA32(wf[nt], af[mt], acc[mt][nt]);
    }
  }
}

template <int MT>
DI void zero_acc(f32x16 (&acc)[MT][2]) {
#pragma unroll
  for (int mt = 0; mt < MT; ++mt)
#pragma unroll
    for (int nt = 0; nt < 2; ++nt)
#pragma unroll
      for (int r = 0; r < 16; ++r) acc[mt][nt][r] = 0.f;
}

#define XB_SIMPLE 0
#define XB_CNT(j) (64 * (1 + (j)))
#define XB_XSUB(j) (64 * (17 + (j)))
#define XB_XGEN(j) (64 * (33 + (j)))
#define XB_TOP (64 * 49)
#define XB_TOPGEN (64 * 50)
#define XB_WORDS (64 * 51)
struct GBar { unsigned* w; unsigned x, nloc, nx, k; };
DI unsigned xb_ld(unsigned* p) { return __hip_atomic_load(p, __ATOMIC_RELAXED, __HIP_MEMORY_SCOPE_AGENT); }
DI unsigned xb_add(unsigned* p, unsigned v) { return __hip_atomic_fetch_add(p, v, __ATOMIC_RELAXED, __HIP_MEMORY_SCOPE_AGENT); }
DI void gbar_init(GBar& b, unsigned* w) {
  b.w = w; b.k = 0; b.nloc = 1; b.nx = 1;
  b.x = (unsigned)__builtin_amdgcn_s_getreg((3 << 11) | 20) & 0xFu;
  if (threadIdx.x == 0) {
    const unsigned r0 = xb_add(&w[XB_CNT(b.x)], 1u);
    asm volatile("s_waitcnt vmcnt(0)" ::"v"(r0) : "memory");
    xb_add(&w[XB_SIMPLE], 1u);
    while (xb_ld(&w[XB_SIMPLE]) < gridDim.x) __builtin_amdgcn_s_sleep(1);
    unsigned mine = 1u, cnt = 0u;
    for (unsigned j = 0; j < 16; ++j) { const unsigned c = xb_ld(&w[XB_CNT(j)]); cnt += (c > 0u) ? 1u : 0u; mine = (j == b.x) ? c : mine; }
    b.nloc = mine; b.nx = cnt;
  }
  __syncthreads();
}
DI void gsync(GBar& b) {
  asm volatile("s_waitcnt vmcnt(0)" ::: "memory");
  __syncthreads();
  if (threadIdx.x == 0) {
    unsigned* w = b.w;
    const unsigned gen = b.k;
    const unsigned old = xb_add(&w[XB_XSUB(b.x)], 1u);
    if (old + 1u == (gen + 1u) * b.nloc) {
      __builtin_amdgcn_fence(__ATOMIC_RELEASE, "agent");
      asm volatile("s_waitcnt vmcnt(0)" ::: "memory");
      const unsigned og = xb_add(&w[XB_TOP], 1u);
      if (og + 1u == (gen + 1u) * b.nx) xb_add(&w[XB_TOPGEN], 1u);
      else while (xb_ld(&w[XB_TOPGEN]) == gen) __builtin_amdgcn_s_sleep(1);
      __builtin_amdgcn_fence(__ATOMIC_ACQUIRE, "agent");
      xb_add(&w[XB_XGEN(b.x)], 1u);
      asm volatile("s_waitcnt vmcnt(0)" ::: "memory");
    } else {
      while (xb_ld(&w[XB_XGEN(b.x)]) == gen) __builtin_amdgcn_s_sleep(1);
      __builtin_amdgcn_fence(__ATOMIC_ACQUIRE, "agent");
      asm volatile("s_waitcnt vmcnt(0)" ::: "memory");
    }
  }
  b.k += 1;
  __syncthreads();
}

DI bool tile_map(int it, int nM, int nN, int& tm, int& tn) {
  const int ntiles = nM * nN, per = (ntiles + 7) >> 3;
  const int xcd = blockIdx.x & 7, local = (blockIdx.x >> 3) + it * (gridDim.x >> 3);
  if (local >= per) return false;
  const int q = xcd * per + local;
  if (q >= ntiles) return false;
  const int grp = q / (8 * nN), fm = grp * 8, gsz = min(nM - fm, 8), within = q - grp * 8 * nN;
  tm = fm + within % gsz; tn = within / gsz;
  return true;
}

DI void tile_of(int q, int nM, int nN, int& tm, int& tn) {
  const int grp = q / (8 * nN), fm = grp * 8, gsz = min(nM - fm, 8), within = q - grp * 8 * nN;
  tm = fm + within % gsz; tn = within / gsz;
}
template <int MT>
DI void plain_tile(const bfu* A, int lda, const bfu* W, int ldw, int K, bfu* C, int ldc, int m0, int n0, char* smem) {
  const int tid_ = otid(), lane = tid_ & 63, wid = tid_ >> 6, wm = wid >> 1, wn = wid & 1;
  f32x16 acc[MT][2];
  zero_acc<MT>(acc);
  gemm_tile<MT>(A + (size_t)m0 * lda, lda, W + (size_t)n0 * ldw, ldw, K, acc, smem);
  __syncthreads();
  {
    char* cs = smem;
#pragma unroll
    for (int mt = 0; mt < MT; ++mt) {
      const int m = wm * 32 * MT + mt * 32 + (lane & 31), sw = m & 31;
#pragma unroll
      for (int nt = 0; nt < 2; ++nt)
#pragma unroll
        for (int g4 = 0; g4 < 4; ++g4) {
          const int c8 = (wn * 64 + nt * 32 + 8 * g4 + 4 * (lane >> 5)) >> 2;
          uint2 pk;
          pk.x = pk2(acc[mt][nt][4 * g4], acc[mt][nt][4 * g4 + 1]);
          pk.y = pk2(acc[mt][nt][4 * g4 + 2], acc[mt][nt][4 * g4 + 3]);
          *(uint2*)(cs + m * 256 + ((c8 ^ sw) << 3)) = pk;
        }
    }
  }
  __syncthreads();
  {
    const char* cs = smem;
    const int jj = tid_ & 15;
#pragma unroll
    for (int i = 0; i < 4 * MT; ++i) {
      const int row = (tid_ >> 4) + 16 * i, sw = row & 31;
      uint4 v = *(const uint4*)(cs + row * 256 + ((jj ^ (sw >> 1)) << 4));
      if (sw & 1) { const unsigned t0 = v.x, t1 = v.y; v.x = v.z; v.y = v.w; v.z = t0; v.w = t1; }
      *(uint4*)(C + (size_t)(m0 + row) * ldc + n0 + jj * 8) = v;
    }
  }
}
DI void gemm_plain(const bfu* A, int lda, const bfu* W, int ldw, int K, int N, bfu* C, int ldc, char* smem) {
  const int nM = T_ALL / 256, nN = N / 128, ntiles = nM * nN, G = gridDim.x;
  const int rem = ntiles % G;
  const bool split = (rem > 0) && (rem * 4 <= G) && ((G & 7) == 0);
  if (!split) {
    for (int it = 0;; ++it) {
      int tm, tn;
      if (!tile_map(it, nM, nN, tm, tn)) break;
      plain_tile<4>(A, lda, W, ldw, K, C, ldc, tm * 256, tn * 128, smem);
    }
    return;
  }
  const int nfull = ntiles - rem, per = nfull >> 3;
  const int xcd = blockIdx.x & 7, slots = G >> 3;
  for (int local = blockIdx.x >> 3; local < per; local += slots) {
    int tm, tn;
    tile_of(xcd * per + local, nM, nN, tm, tn);
    plain_tile<4>(A, lda, W, ldw, K, C, ldc, tm * 256, tn * 128, smem);
  }
  for (int sidx = blockIdx.x; sidx < rem * 4; sidx += G) {
    int tm, tn;
    tile_of(nfull + (sidx >> 2), nM, nN, tm, tn);
    plain_tile<1>(A, lda, W, ldw, K, C, ldc, tm * 256 + (sidx & 3) * 64, tn * 128, smem);
  }
}

DI void gemm_glu(const Params& P, int l, char* smem) {
  bfu* PJ = (bfu*)(P.ws + WS_PROJ);
  const bfu* W = (const bfu*)(P.ws + WS_GLU);
  const float* gb = P.in[30] + l * 512;
  const int nM = T_ALL / 256, nN = 4;
  const int tid_ = otid(), lane = tid_ & 63, wid = tid_ >> 6, wm = wid >> 1, wn = wid & 1;
  for (int it = 0;; ++it) {
    int tm, tn;
    if (!tile_map(it, nM, nN, tm, tn)) break;
    f32x16 acc[4][2];
    zero_acc<4>(acc);
    gemm_tile<4>(PJ + (size_t)tm * 256 * NPJ + C_S5U, NPJ, W + (size_t)tn * 128 * 512, 512, 512, acc, smem);
#pragma unroll
    for (int mt = 0; mt < 4; ++mt) {
      const int m = tm * 256 + wm * 128 + mt * 32 + (lane & 31);
#pragma unroll
      for (int nt = 0; nt < 2; ++nt)
#pragma unroll
        for (int g4 = 0; g4 < 4; ++g4) {
          const int n = tn * 128 + wn * 64 + nt * 32 + 8 * g4 + 4 * (lane >> 5);
          const uint2 yv = *(const uint2*)(PJ + (size_t)m * NPJ + C_S5U + n);
          const float4 bv = *(const float4*)(gb + n);
          const float y0 = bf2f((bfu)(yv.x & 0xffff)), y1 = bf2f((bfu)(yv.x >> 16)), y2 = bf2f((bfu)(yv.y & 0xffff)), y3 = bf2f((bfu)(yv.y >> 16));
          uint2 pk;
          pk.x = pk2(y0 * sigm(acc[mt][nt][4 * g4] + bv.x), y1 * sigm(acc[mt][nt][4 * g4 + 1] + bv.y));
          pk.y = pk2(y2 * sigm(acc[mt][nt][4 * g4 + 2] + bv.z), y3 * sigm(acc[mt][nt][4 * g4 + 3] + bv.w));
          *(uint2*)(PJ + (size_t)m * NPJ + C_RGX + n) = pk;
        }
    }
  }
}

DI void gemm_ffn1(const Params& P, char* smem) {
  const bfu* A = (const bfu*)(P.ws + WS_H);
  const bfu* W = (const bfu*)(P.ws + WS_WGU);
  bfu* C = (bfu*)(P.ws + WS_ACT);
  const int nM = T_ALL / 256, nN = 44;
  const int tid_ = otid(), lane = tid_ & 63, wid = tid_ >> 6, wm = wid >> 1, wn = wid & 1;
  for (int it = 0;; ++it) {
    int tm, tn;
    if (!tile_map(it, nM, nN, tm, tn)) break;
    f32x16 acc[4][2];
    zero_acc<4>(acc);
    gemm_tile<4>(A + (size_t)tm * 256 * 1024, 1024, W + (size_t)tn * 128 * 1024, 1024, 1024, acc, smem);
#pragma unroll
    for (int mt = 0; mt < 4; ++mt) {
      const int m = tm * 256 + wm * 128 + mt * 32 + (lane & 31);
#pragma unroll
      for (int g4 = 0; g4 < 4; ++g4) {
        const int j = tn * 64 + wn * 32 + 8 * g4 + 4 * (lane >> 5);
        uint2 pk;
        pk.x = pk2(siluf(acc[mt][0][4 * g4]) * acc[mt][1][4 * g4], siluf(acc[mt][0][4 * g4 + 1]) * acc[mt][1][4 * g4 + 1]);
        pk.y = pk2(siluf(acc[mt][0][4 * g4 + 2]) * acc[mt][1][4 * g4 + 2], siluf(acc[mt][0][4 * g4 + 3]) * acc[mt][1][4 * g4 + 3]);
        *(uint2*)(C + (size_t)m * 2816 + j) = pk;
      }
    }
  }
}

template <int MT>
DI void merge_tile(const Params& P, int m0, int tn, char* smem) {
  const bfu* H = (const bfu*)(P.ws + WS_H);
  const bfu* PJ = (const bfu*)(P.ws + WS_PROJ);
  const bfu* WIN = (const bfu*)(P.ws + WS_WIN);
  bfu* C = (bfu*)(P.ws + WS_MIXED);
  const int tid_ = otid(), lane = tid_ & 63, wid = tid_ >> 6, wm = wid >> 1, wn = wid & 1;
  f32x16 tot[MT][2];
  zero_acc<MT>(tot);
#pragma unroll 1
  for (int b = 0; b < 3; ++b) {
    unsigned* gps = (unsigned*)(smem + 36864) + tid_;
    unsigned gkeep[4] = {0u, 0u, 0u, 0u};
    {
      f32x16 g[MT][2];
      zero_acc<MT>(g);
      gemm_tile<MT>(H + (size_t)m0 * 1024, 1024, WIN + (size_t)(3584 + b * 1024 + tn * 128) * 1024, 1024, 1024, g, smem);
#pragma unroll
      for (int mt = 0; mt < MT; ++mt)
#pragma unroll
        for (int nt = 0; nt < 2; ++nt)
#pragma unroll
          for (int r = 0; r < 8; ++r) {
            const unsigned pv = pk2(sigm(g[mt][nt][2 * r]), sigm(g[mt][nt][2 * r + 1]));
            if ((mt * 2 + nt) * 8 + r < 28) gps[((mt * 2 + nt) * 8 + r) * 256] = pv;
            else gkeep[((mt * 2 + nt) * 8 + r) - 28] = pv;
          }
    }
    const int colb = (b == 0) ? C_RGG : (b == 1 ? C_RGX : C_Z);
    const bfu* Wo = (const bfu*)(P.ws + (b == 0 ? WS_RGO : (b == 1 ? WS_S5O : WS_GDO)));
    f32x16 y[MT][2];
    zero_acc<MT>(y);
    gemm_tile<MT>(PJ + (size_t)m0 * NPJ + colb, NPJ, Wo + (size_t)tn * 128 * 512, 512, 512, y, smem);
#pragma unroll
    for (int mt = 0; mt < MT; ++mt)
#pragma unroll
      for (int nt = 0; nt < 2; ++nt)
#pragma unroll
        for (int r = 0; r < 8; ++r) {
          const unsigned gv = ((mt * 2 + nt) * 8 + r < 28) ? gps[((mt * 2 + nt) * 8 + r) * 256] : gkeep[((mt * 2 + nt) * 8 + r) - 28];
          tot[mt][nt][2 * r] += __uint_as_float(gv << 16) * y[mt][nt][2 * r];
          tot[mt][nt][2 * r + 1] += __uint_as_float(gv & 0xffff0000u) * y[mt][nt][2 * r + 1];
        }
  }
#pragma unroll
  for (int mt = 0; mt < MT; ++mt) {
    const int m = m0 + wm * 32 * MT + mt * 32 + (lane & 31);
#pragma unroll
    for (int nt = 0; nt < 2; ++nt)
#pragma unroll
      for (int g4 = 0; g4 < 4; ++g4) {
        const int n = tn * 128 + wn * 64 + nt * 32 + 8 * g4 + 4 * (lane >> 5);
        uint2 pk;
        pk.x = pk2(tot[mt][nt][4 * g4], tot[mt][nt][4 * g4 + 1]);
        pk.y = pk2(tot[mt][nt][4 * g4 + 2], tot[mt][nt][4 * g4 + 3]);
        *(uint2*)(C + (size_t)m * 1024 + n) = pk;
      }
  }
}
DI void gemm_merge(const Params& P, char* smem) {
  const int nM = T_ALL / 128, nN = 8, ntiles = nM * nN, G = gridDim.x;
  const int rem = ntiles % G;
  const bool split = (rem > 0) && (rem * 2 <= G / 2) && ((G & 7) == 0);
  if (!split) {
    for (int it = 0;; ++it) {
      int tm, tn;
      if (!tile_map(it, nM, nN, tm, tn)) break;
      merge_tile<2>(P, tm * 128, tn, smem);
    }
    return;
  }
  const int nfull = ntiles - rem, per = nfull >> 3;
  const int xcd = blockIdx.x & 7, slots = G >> 3;
  for (int local = blockIdx.x >> 3; local < per; local += slots) {
    int tm, tn;
    tile_of(xcd * per + local, nM, nN, tm, tn);
    merge_tile<2>(P, tm * 128, tn, smem);
  }
  for (int sidx = blockIdx.x; sidx < rem * 2; sidx += G) {
    int tm, tn;
    tile_of(nfull + (sidx >> 1), nM, nN, tm, tn);
    merge_tile<1>(P, tm * 128 + (sidx & 1) * 64, tn, smem);
  }
}

DI void cvt_job(const float* src, int ld, int K, int ncols, bfu* dst, int ldd, int mode, float* sm) {
  const int nkt = K >> 6, nnt = ncols >> 6, nt = nkt * nnt;
  const int tid = otid();
  for (int t = blockIdx.x; t < nt; t += gridDim.x) {
    const int kt = t % nkt, ct = t / nkt;
    const int k0 = kt * 64, c0 = ct * 64;
    float4 v[4];
#pragma unroll
    for (int i = 0; i < 4; ++i) v[i] = *(const float4*)(src + (size_t)(k0 + (tid >> 4) + 16 * i) * ld + c0 + (tid & 15) * 4);
    __syncthreads();
#pragma unroll
    for (int i = 0; i < 4; ++i) {
      const int k = (tid >> 4) + 16 * i, n = (tid & 15) * 4;
      sm[(n + 0) * 65 + k] = v[i].x; sm[(n + 1) * 65 + k] = v[i].y; sm[(n + 2) * 65 + k] = v[i].z; sm[(n + 3) * 65 + k] = v[i].w;
    }
    __syncthreads();
    const int n = tid >> 2, ks = (tid & 3) * 16;
    const int row = (mode == 0) ? (c0 + n) : (ct * 128 + (n >> 5) * 64 + (mode - 1) * 32 + (n & 31));
    uint4 w0, w1;
    const float* r = sm + n * 65 + ks;
    w0.x = pk2(r[0], r[1]); w0.y = pk2(r[2], r[3]); w0.z = pk2(r[4], r[5]); w0.w = pk2(r[6], r[7]);
    w1.x = pk2(r[8], r[9]); w1.y = pk2(r[10], r[11]); w1.z = pk2(r[12], r[13]); w1.w = pk2(r[14], r[15]);
    *(uint4*)(dst + (size_t)row * ldd + k0 + ks) = w0;
    *(uint4*)(dst + (size_t)row * ldd + k0 + ks + 8) = w1;
  }
}

DI void prep_layer(const Params& P, int l, char* smem) {
  float* sm = (float*)smem;
  char* ws = P.ws;
  cvt_job(P.in[12] + (size_t)l * 1024 * 6664, 6664, 1024, 3584, (bfu*)(ws + WS_WIN), 1024, 0, sm);
  cvt_job(P.in[12] + (size_t)l * 1024 * 6664 + 3592, 6664, 1024, 3072, (bfu*)(ws + WS_WIN) + (size_t)3584 * 1024, 1024, 0, sm);
  cvt_job(P.in[20] + (size_t)l * 512 * 1024, 1024, 512, 1024, (bfu*)(ws + WS_RGO), 512, 0, sm);
  cvt_job(P.in[31] + (size_t)l * 512 * 1024, 1024, 512, 1024, (bfu*)(ws + WS_S5O), 512, 0, sm);
  cvt_job(P.in[36] + (size_t)l * 512 * 1024, 1024, 512, 1024, (bfu*)(ws + WS_GDO), 512, 0, sm);
  cvt_job(P.in[29] + (size_t)l * 512 * 512, 512, 512, 512, (bfu*)(ws + WS_GLU), 512, 0, sm);
  cvt_job(P.in[37] + (size_t)l * 1024 * 1024, 1024, 1024, 1024, (bfu*)(ws + WS_WOUT), 1024, 0, sm);
  cvt_job(P.in[38] + (size_t)l * 1024 * 2816, 2816, 1024, 2816, (bfu*)(ws + WS_WGU), 1024, 1, sm);
  cvt_job(P.in[39] + (size_t)l * 1024 * 2816, 2816, 1024, 2816, (bfu*)(ws + WS_WGU), 1024, 2, sm);
  cvt_job(P.in[40] + (size_t)l * 2816 * 1024, 1024, 2816, 1024, (bfu*)(ws + WS_WDN), 2816, 0, sm);
#pragma unroll 1
  for (int n = 0; n < 8; ++n) {
    cvt_job(P.in[15] + (size_t)(l * 8 + n) * 4096, 64, 64, 64, (bfu*)(ws + WS_RGW) + (size_t)n * 8192, 64, 0, sm);
    cvt_job(P.in[17] + (size_t)(l * 8 + n) * 4096, 64, 64, 64, (bfu*)(ws + WS_RGW) + (size_t)n * 8192 + 4096, 64, 0, sm);
  }
  bfu* BB = (bfu*)(ws + WS_S5BB);
  bfu* CC = (bfu*)(ws + WS_S5CC);
  float* LAM = (float*)(ws + WS_S5LAM);
  for (int idx = blockIdx.x * 256 + otid(); idx < 2048; idx += gridDim.x * 256) {
    const int g = idx >> 6, p = idx & 63;
    const float ar = P.in[21][l * 2048 + idx], ai = P.in[22][l * 2048 + idx];
    const float dt = expf(P.in[28][l * 32 + g]);
    const float mag = expf(ar * dt), ang = ai * dt;
    const float lr = mag * cosf(ang), li = mag * sinf(ang);
    LAM[idx * 2] = lr; LAM[idx * 2 + 1] = li;
    const float den = 1.f / (ar * ar + ai * ai);
    const float cr = ((lr - 1.f) * ar + li * ai) * den, ci = (li * ar - (lr - 1.f) * ai) * den;
    const float* bre = P.in[23] + ((size_t)(l * 32 + g) * 64 + p) * 16;
    const float* bim = P.in[24] + ((size_t)(l * 32 + g) * 64 + p) * 16;
    for (int h = 0; h < 16; ++h) {
      const float br = bre[h], bi = bim[h];
      BB[(size_t)(g * 128 + p) * 16 + h] = f2bf(cr * br - ci * bi);
      BB[(size_t)(g * 128 + 64 + p) * 16 + h] = f2bf(cr * bi + ci * br);
      CC[(size_t)(g * 16 + h) * 128 + p] = f2bf(P.in[25][((size_t)(l * 32 + g) * 16 + h) * 64 + p]);
      CC[(size_t)(g * 16 + h) * 128 + 64 + p] = f2bf(-P.in[26][((size_t)(l * 32 + g) * 16 + h) * 64 + p]);
    }
  }
}

DI void norm_pass(const Params& P, int l, int mode, char* smem) {
  const int tid_ = otid(), lane = tid_ & 63, wid = tid_ >> 6;
  const int nw = gridDim.x * 4, gw = blockIdx.x * 4 + wid;
  const bfu* src = (const bfu*)(P.ws + (mode == 1 ? WS_MO : WS_FO));
  const float* gA = (mode == 1 ? P.in[9] : P.in[11]) + l * 1024;
  const bool doH = (mode != 2) || (l == 0);
  const float* gB = (mode == 0) ? P.in[8] : (mode == 1 ? P.in[10] + l * 1024 : P.in[8] + 1024);
  const bool doAB = (mode == 0) || (mode == 2 && l == 0);
  const int lab = (mode == 0) ? 0 : 1;
  const float* W8 = P.in[12] + (size_t)lab * 1024 * 6664 + 3584;
  bfu* H = (bfu*)(P.ws + WS_H);
  float* AB = (float*)(P.ws + WS_AB);
  float* W8s = (float*)smem;
  if (doAB) {
    __syncthreads();
    for (int idx = tid_; idx < 8192; idx += 256) W8s[(idx & 7) * 1024 + (idx >> 3)] = W8[(size_t)(idx >> 3) * 6664 + (idx & 7)];
    __syncthreads();
  }
  for (int r = gw; r < T_ALL; r += nw) {
    float4 xv[4];
    float* xo = P.out + (size_t)r * 1024;
    if (mode == 0) {
      const float* xi = (r < TP) ? (P.in[0] + (size_t)r * 1024) : (P.in[1] + (size_t)(r - TP) * 1024);
#pragma unroll
      for (int i = 0; i < 4; ++i) xv[i] = *(const float4*)(xi + lane * 4 + 256 * i);
    } else {
      float4 av[4];
      float ss = 0.f;
#pragma unroll
      for (int i = 0; i < 4; ++i) {
        xv[i] = *(const float4*)(xo + lane * 4 + 256 * i);
        const uint2 s2 = *(const uint2*)(src + (size_t)r * 1024 + lane * 4 + 256 * i);
        av[i].x = bf2f((bfu)(s2.x & 0xffff)); av[i].y = bf2f((bfu)(s2.x >> 16));
        av[i].z = bf2f((bfu)(s2.y & 0xffff)); av[i].w = bf2f((bfu)(s2.y >> 16));
        ss += av[i].x * av[i].x + av[i].y * av[i].y + av[i].z * av[i].z + av[i].w * av[i].w;
      }
      ss = wsum(ss);
      const float sa = rsqrtf(ss * (1.f / 1024.f) + 1e-6f);
#pragma unroll
      for (int i = 0; i < 4; ++i) {
        const float4 gv = *(const float4*)(gA + lane * 4 + 256 * i);
        xv[i].x += av[i].x * sa * gv.x; xv[i].y += av[i].y * sa * gv.y;
        xv[i].z += av[i].z * sa * gv.z; xv[i].w += av[i].w * sa * gv.w;
      }
    }
#pragma unroll
    for (int i = 0; i < 4; ++i) *(float4*)(xo + lane * 4 + 256 * i) = xv[i];
    if (doH) {
      float ss = 0.f;
#pragma unroll
      for (int i = 0; i < 4; ++i) ss += xv[i].x * xv[i].x + xv[i].y * xv[i].y + xv[i].z * xv[i].z + xv[i].w * xv[i].w;
      ss = wsum(ss);
      const float sc = rsqrtf(ss * (1.f / 1024.f) + 1e-6f);
      float ab[8];
#pragma unroll
      for (int j = 0; j < 8; ++j) ab[j] = 0.f;
#pragma unroll
      for (int i = 0; i < 4; ++i) {
        const float4 gv = *(const float4*)(gB + lane * 4 + 256 * i);
        float hv[4] = {xv[i].x * sc * gv.x, xv[i].y * sc * gv.y, xv[i].z * sc * gv.z, xv[i].w * sc * gv.w};
        uint2 pk;
        pk.x = pk2(hv[0], hv[1]); pk.y = pk2(hv[2], hv[3]);
        *(uint2*)(H + (size_t)r * 1024 + lane * 4 + 256 * i) = pk;
        if (doAB) {
#pragma unroll
          for (int j = 0; j < 8; ++j) {
            const float4 wj = *(const float4*)(W8s + j * 1024 + lane * 4 + 256 * i);
            ab[j] += hv[0] * wj.x; ab[j] += hv[1] * wj.y; ab[j] += hv[2] * wj.z; ab[j] += hv[3] * wj.w;
          }
        }
      }
      if (doAB) {
#pragma unroll
        for (int j = 0; j < 8; ++j) ab[j] = wsum(ab[j]);
        if (lane == 0) {
          *(float4*)(AB + (size_t)r * 8) = make_float4(ab[0], ab[1], ab[2], ab[3]);
          *(float4*)(AB + (size_t)r * 8 + 4) = make_float4(ab[4], ab[5], ab[6], ab[7]);
        }
      }
    }
  }
}

DI void rg_task(const Params& P, int l, int chunk, int n, int mode, char* smem) {
  float* xc_f = (float*)smem;
  bfu* xc_b = (bfu*)(xc_f + 64 * 65);
  float* a_s = (float*)(xc_b + 64 * 72);
  float* in_s = a_s + 4096;
  float* segP = in_s + 4096;
  float* segH = segP + 512;
  float* car = segH + 512;
  float* part = car + 64;
  const int tid = otid(), lane = tid & 63, wid = tid >> 6;
  bfu* PJ = (bfu*)(P.ws + WS_PROJ);
  const int tok0 = chunk * 64;
  const bool isS = chunk >= 256;
  const int c = tid & 63, tq = tid >> 6, cc = n * 64 + c;
  const bfu* RGW = (const bfu*)(P.ws + WS_RGW) + (size_t)n * 8192;
  bf16x8 wbr[4], wbi[4];
#pragma unroll
  for (int ks = 0; ks < 4; ++ks) {
    wbr[ks] = *(const bf16x8*)(RGW + ((wid & 1) * 32 + (lane & 31)) * 64 + ks * 16 + (lane >> 5) * 8);
    wbi[ks] = *(const bf16x8*)(RGW + (64 + (wid & 1) * 32 + (lane & 31)) * 64 + ks * 16 + (lane >> 5) * 8);
  }
  const int cch0 = n * 64 + (wid & 1) * 32 + (lane & 31);
  const float ba = P.in[16][l * 512 + cch0], bx = P.in[18][l * 512 + cch0];
  const float sp = softplusf(-P.in[19][l * 512 + cch0]);
  float gt2[2][8];
  float2 rprev[8];
  float* RGSUM = (float*)(P.ws + WS_RGSUM);
  if (mode != 0) {
#pragma unroll
    for (int q = 0; q < 2; ++q)
#pragma unroll
      for (int tt = 0; tt < 8; ++tt) gt2[q][tt] = bf2f(PJ[(size_t)(tok0 + (tq + 4 * q) * 8 + tt) * NPJ + C_RGG + cc]);
    if (!isS) {
      const int ci = chunk & 31, cs = chunk & ~31;
#pragma unroll
      for (int i = 0; i < 8; ++i) {
        const int c2 = tq * 8 + i;
        rprev[i] = (c2 < ci) ? *(const float2*)(RGSUM + ((size_t)(cs + c2) * 512 + cc) * 2) : make_float2(1.f, 0.f);
      }
    }
  }
  {
    const float* cw = P.in[13] + l * 2048;
    const float w0 = cw[cc], w1 = cw[512 + cc], w2 = cw[1024 + cc], w3 = cw[1536 + cc], cb = P.in[14][l * 512 + cc];
    if (!isS) {
      bfu* xs = (bfu*)a_s;
      const bool first = (chunk & 31) == 0;
#pragma unroll
      for (int j = 0; j < 3; ++j) {
        const int idx = tid + 256 * j;
        if (idx < 67 * 8) {
          const int row = idx >> 3, ch = idx & 7;
          u32x4 v = {0u, 0u, 0u, 0u};
          if (!(first && row < 3)) v = *(const u32x4*)(PJ + (size_t)(tok0 - 3 + row) * NPJ + C_RGX + n * 64 + ch * 8);
          *(u32x4*)(xs + row * 64 + ch * 8) = v;
        }
      }
      __syncthreads();
#pragma unroll 4
      for (int i = 0; i < 16; ++i) {
        const int t = tq + 4 * i;
        const float acc = cb + w0 * bf2f(xs[t * 64 + c]) + w1 * bf2f(xs[(t + 1) * 64 + c]) + w2 * bf2f(xs[(t + 2) * 64 + c]) + w3 * bf2f(xs[(t + 3) * 64 + c]);
        xc_f[t * 65 + c] = acc;
        xc_b[t * 72 + c] = f2bf(acc);
      }
    } else {
#pragma unroll 4
      for (int i = 0; i < 16; ++i) {
        const int t = tq + 4 * i, tok = tok0 + t, tl = tok & 7;
        float xk[4];
#pragma unroll
        for (int k = 0; k < 4; ++k) {
          const int j = tl + k - 3;
          if (j >= 0) xk[k] = bf2f(PJ[(size_t)(tok + k - 3) * NPJ + C_RGX + cc]);
          else xk[k] = P.in[2][((size_t)(l * 128 + ((tok - TP) >> 3)) * 3 + (tl + k)) * 512 + cc];
        }
        const float acc = cb + w0 * xk[0] + w1 * xk[1] + w2 * xk[2] + w3 * xk[3];
        xc_f[t * 65 + c] = acc;
        xc_b[t * 72 + c] = f2bf(acc);
      }
    }
  }
  __syncthreads();
  {
    const int mt = wid >> 1, ntl = wid & 1;
    f32x16 R, I;
#pragma unroll
    for (int r = 0; r < 16; ++r) { R[r] = 0.f; I[r] = 0.f; }
#pragma unroll
    for (int ks = 0; ks < 4; ++ks) {
      const bf16x8 a = *(const bf16x8*)(xc_b + (mt * 32 + (lane & 31)) * 72 + ks * 16 + (lane >> 5) * 8);
      R = MFMA32(a, wbr[ks], R);
      I = MFMA32(a, wbi[ks], I);
    }
    const int ch = ntl * 32 + (lane & 31);
#pragma unroll
    for (int r = 0; r < 16; ++r) {
      const int t = mt * 32 + rowmap(r, lane);
      const float rr = sigm(R[r] + ba), ig = sigm(I[r] + bx);
      const float la = -8.f * rr * sp;
      const float a = __expf(la);
      const float inp = sqrtf(fmaxf(-expm1f(2.f * la), 0.f)) * ig * xc_f[t * 65 + ch];
      a_s[t * 64 + ch] = a;
      in_s[t * 64 + ch] = inp;
    }
  }
  __syncthreads();
#pragma unroll
  for (int q = 0; q < 2; ++q) {
    const int sg = tq + 4 * q;
    float Pp = 1.f, Hh = 0.f;
#pragma unroll
    for (int tt = 0; tt < 8; ++tt) {
      const float a = a_s[(sg * 8 + tt) * 64 + c];
      Hh = a * Hh + in_s[(sg * 8 + tt) * 64 + c];
      Pp *= a;
    }
    segP[sg * 64 + c] = Pp; segH[sg * 64 + c] = Hh;
  }
  __syncthreads();
  if (mode == 0) {
    if (tid < 64) {
      float Pp = 1.f, Hh = 0.f;
#pragma unroll
      for (int sg = 0; sg < 8; ++sg) { Hh = segP[sg * 64 + c] * Hh + segH[sg * 64 + c]; Pp *= segP[sg * 64 + c]; }
      *(float2*)(RGSUM + ((size_t)chunk * 512 + cc) * 2) = make_float2(Pp, Hh);
    }
    return;
  }
  if (!isS) {
    const int ci = chunk & 31, cs = chunk & ~31;
    float Pp = 1.f, Hh = 0.f;
#pragma unroll
    for (int i = 0; i < 8; ++i) {
      const int c2 = tq * 8 + i;
      if (c2 < ci) {
        const float2 ph = rprev[i];
        Hh = ph.x * Hh + ph.y; Pp *= ph.x;
      }
    }
    part[(tq * 64 + c) * 2] = Pp; part[(tq * 64 + c) * 2 + 1] = Hh;
    __syncthreads();
    if (tid < 64) {
      float h = 0.f;
#pragma unroll
      for (int q2 = 0; q2 < 4; ++q2) h = part[(q2 * 64 + c) * 2] * h + part[(q2 * 64 + c) * 2 + 1];
      car[c] = h;
    }
    __syncthreads();
  }
#pragma unroll
  for (int q = 0; q < 2; ++q) {
    const int sg = tq + 4 * q;
    float h;
    const int sseq = (tok0 - TP) / 8 + sg;
    if (isS) h = P.in[3][(size_t)(l * 128 + sseq) * 512 + cc];
    else {
      h = car[c];
      for (int s2 = 0; s2 < sg; ++s2) h = segP[s2 * 64 + c] * h + segH[s2 * 64 + c];
    }
#pragma unroll
    for (int tt = 0; tt < 8; ++tt) {
      const int t = sg * 8 + tt;
      h = a_s[t * 64 + c] * h + in_s[t * 64 + c];
      PJ[(size_t)(tok0 + t) * NPJ + C_RGG + cc] = f2bf(h * geluf(gt2[q][tt]));
    }
    if (isS) P.out[O_SRH + (size_t)(l * 128 + sseq) * 512 + cc] = h;
    else if ((chunk & 31) == 31 && sg == 7) P.out[O_PRH + (size_t)(l * 8 + (chunk >> 5)) * 512 + cc] = h;
  }
  if (isS) {
    for (int idx = tid; idx < 8 * 3 * 64; idx += 256) {
      const int c3 = idx & 63, i = (idx >> 6) % 3, sg = idx / 192;
      const int sseq = (tok0 - TP) / 8 + sg;
      P.out[O_SRC + ((size_t)(l * 128 + sseq) * 3 + i) * 512 + n * 64 + c3] = bf2f(PJ[(size_t)(tok0 + sg * 8 + 5 + i) * NPJ + C_RGX + n * 64 + c3]);
    }
  } else if ((chunk & 31) == 31) {
    if (tid < 192) {
      const int c3 = tid & 63, i = tid >> 6;
      P.out[O_PRC + ((size_t)(l * 8 + (chunk >> 5)) * 3 + i) * 512 + n * 64 + c3] = bf2f(PJ[(size_t)(tok0 + 61 + i) * NPJ + C_RGX + n * 64 + c3]);
    }
  }
}

DI void s5_task(const Params& P, int l, int chunk, int g, int mode, char* smem) {
  float* bu_s = (float*)smem;
  bfu* ss_b = (bfu*)(bu_s + 8192);
  float* segS = (float*)(ss_b + 64 * 136);
  float* car = segS + 1024;
  float* part = car + 128;
  const int tid = otid(), lane = tid & 63, wid = tid >> 6;
  bfu* PJ = (bfu*)(P.ws + WS_PROJ);
  const int tok0 = chunk * 64;
  const bool isS = chunk >= 256;
  const int p = tid & 63, tq = tid >> 6;
  const float* LAMT = (const float*)(P.ws + WS_S5LAM);
  const float lr = LAMT[(g * 64 + p) * 2], li = LAMT[(g * 64 + p) * 2 + 1];
  float* S5SUM = (float*)(P.ws + WS_S5SUM);
  bf16x8 cfr[4];
  float2 sprev[8];
  float uu[4], st0[4];
  const int hh = lane & 15;
  const float dco = P.in[27][l * 512 + g * 16 + hh];
  if (mode != 0) {
    const bfu* CC = (const bfu*)(P.ws + WS_S5CC) + (size_t)g * 2048;
#pragma unroll
    for (int ks = 0; ks < 4; ++ks) cfr[ks] = *(const bf16x8*)(CC + (lane & 15) * 128 + ks * 32 + (lane >> 4) * 8);
#pragma unroll
    for (int r = 0; r < 4; ++r) uu[r] = bf2f(PJ[(size_t)(tok0 + wid * 16 + (lane >> 4) * 4 + r) * NPJ + C_S5U + g * 16 + hh]);
    if (!isS) {
      const int ci = chunk & 31, cs = chunk & ~31;
#pragma unroll
      for (int i = 0; i < 8; ++i) {
        const int c2 = tq * 8 + i;
        sprev[i] = (c2 < ci) ? *(const float2*)(S5SUM + (((size_t)(cs + c2) * 32 + g) * 64 + p) * 2) : make_float2(0.f, 0.f);
      }
    } else {
#pragma unroll
      for (int q = 0; q < 2; ++q) {
        const size_t si0 = ((size_t)(l * 128 + (tok0 - TP) / 8 + tq + 4 * q) * 32 + g) * 64 + p;
        st0[2 * q] = P.in[4][si0]; st0[2 * q + 1] = P.in[5][si0];
      }
    }
  }
  {
    const bfu* BB = (const bfu*)(P.ws + WS_S5BB) + (size_t)g * 2048;
    const bf16x8 b = *(const bf16x8*)(BB + (wid * 32 + (lane & 31)) * 16 + (lane >> 5) * 8);
#pragma unroll
    for (int mt = 0; mt < 2; ++mt) {
      const bf16x8 a = *(const bf16x8*)(PJ + (size_t)(tok0 + mt * 32 + (lane & 31)) * NPJ + C_S5U + g * 16 + (lane >> 5) * 8);
      f32x16 d;
#pragma unroll
      for (int r = 0; r < 16; ++r) d[r] = 0.f;
      d = MFMA32(a, b, d);
#pragma unroll
      for (int r = 0; r < 16; ++r) bu_s[(mt * 32 + rowmap(r, lane)) * 128 + wid * 32 + (lane & 31)] = d[r];
    }
  }
  __syncthreads();
#pragma unroll
  for (int q = 0; q < 2; ++q) {
    const int sg = tq + 4 * q;
    float sr = 0.f, si = 0.f;
#pragma unroll
    for (int tt = 0; tt < 8; ++tt) {
      const int t = sg * 8 + tt;
      const float nr = lr * sr - li * si + bu_s[t * 128 + p];
      const float ni = lr * si + li * sr + bu_s[t * 128 + 64 + p];
      sr = nr; si = ni;
    }
    segS[(sg * 64 + p) * 2] = sr; segS[(sg * 64 + p) * 2 + 1] = si;
  }
  __syncthreads();
  float l8r = lr, l8i = li;
#pragma unroll
  for (int k = 0; k < 3; ++k) { const float nr = l8r * l8r - l8i * l8i, ni = 2.f * l8r * l8i; l8r = nr; l8i = ni; }
  if (mode == 0) {
    if (tid < 64) {
      float sr = 0.f, si = 0.f;
#pragma unroll
      for (int sg = 0; sg < 8; ++sg) {
        const float nr = l8r * sr - l8i * si + segS[(sg * 64 + p) * 2];
        const float ni = l8r * si + l8i * sr + segS[(sg * 64 + p) * 2 + 1];
        sr = nr; si = ni;
      }
      *(float2*)(S5SUM + (((size_t)chunk * 32 + g) * 64 + p) * 2) = make_float2(sr, si);
    }
    return;
  }
  if (!isS) {
    float l64r = l8r, l64i = l8i;
#pragma unroll
    for (int k = 0; k < 3; ++k) { const float nr = l64r * l64r - l64i * l64i, ni = 2.f * l64r * l64i; l64r = nr; l64i = ni; }
    const int ci = chunk & 31, cs = chunk & ~31;
    float ar = 0.f, ai = 0.f;
#pragma unroll
    for (int i = 0; i < 8; ++i) {
      const int c2 = tq * 8 + i;
      if (c2 < ci) {
        const float2 sv = sprev[i];
        const float nr = l64r * ar - l64i * ai + sv.x, ni = l64r * ai + l64i * ar + sv.y;
        ar = nr; ai = ni;
      }
    }
    part[(tq * 64 + p) * 2] = ar; part[(tq * 64 + p) * 2 + 1] = ai;
    __syncthreads();
    if (tid < 64) {
      float cr = 0.f, cim = 0.f;
      for (int q2 = 0; q2 < 4; ++q2) {
        const int cnt = min(max(ci - q2 * 8, 0), 8);
        for (int k = 0; k < cnt; ++k) { const float nr = l64r * cr - l64i * cim, ni = l64r * cim + l64i * cr; cr = nr; cim = ni; }
        cr += part[(q2 * 64 + p) * 2]; cim += part[(q2 * 64 + p) * 2 + 1];
      }
      car[p * 2] = cr; car[p * 2 + 1] = cim;
    }
    __syncthreads();
  }
#pragma unroll
  for (int q = 0; q < 2; ++q) {
    const int sg = tq + 4 * q;
    const int sseq = (tok0 - TP) / 8 + sg;
    float sr, si;
    if (isS) {
      sr = st0[2 * q]; si = st0[2 * q + 1];
    } else {
      sr = car[p * 2]; si = car[p * 2 + 1];
      for (int s2 = 0; s2 < sg; ++s2) {
        const float nr = l8r * sr - l8i * si + segS[(s2 * 64 + p) * 2];
        const float ni = l8r * si + l8i * sr + segS[(s2 * 64 + p) * 2 + 1];
        sr = nr; si = ni;
      }
    }
#pragma unroll
    for (int tt = 0; tt < 8; ++tt) {
      const int t = sg * 8 + tt;
      const float nr = lr * sr - li * si + bu_s[t * 128 + p];
      const float ni = lr * si + li * sr + bu_s[t * 128 + 64 + p];
      sr = nr; si = ni;
      ss_b[t * 136 + p] = f2bf(sr);
      ss_b[t * 136 + 64 + p] = f2bf(si);
    }
    if (isS) {
      const size_t so = ((size_t)(l * 128 + sseq) * 32 + g) * 64 + p;
      P.out[O_SSR + so] = sr; P.out[O_SSI + so] = si;
    } else if ((chunk & 31) == 31 && sg == 7) {
      const size_t so = ((size_t)(l * 8 + (chunk >> 5)) * 32 + g) * 64 + p;
      P.out[O_PSR + so] = sr; P.out[O_PSI + so] = si;
    }
  }
  __syncthreads();
  {
    f32x4 acc = {0.f, 0.f, 0.f, 0.f};
#pragma unroll
    for (int ks = 0; ks < 4; ++ks) {
      const bf16x8 a = *(const bf16x8*)(ss_b + (wid * 16 + (lane & 15)) * 136 + ks * 32 + (lane >> 4) * 8);
      acc = MFMA16(a, cfr[ks], acc);
    }
    const int h = hh;
#pragma unroll
    for (int r = 0; r < 4; ++r) {
      const int t = wid * 16 + (lane >> 4) * 4 + r;
      PJ[(size_t)(tok0 + t) * NPJ + C_S5U + g * 16 + h] = f2bf(geluf(acc[r] + dco * uu[r]));
    }
  }
}

DI void gdn_conv_col(const Params& P, int l, int chunk, int ch, float (&v)[64]) {
  const bfu* PJ = (const bfu*)(P.ws + WS_PROJ);
  const int tok0 = chunk * 64;
  const bool isS = chunk >= 256;
  const float* cw = P.in[32] + l * 4 * 1536;
  const float w0 = cw[ch], w1 = cw[1536 + ch], w2 = cw[2 * 1536 + ch], w3 = cw[3 * 1536 + ch];
  float x3 = 0.f, x2 = 0.f, x1 = 0.f;
  if (!isS && (chunk & 31) != 0) {
    x3 = bf2f(PJ[(size_t)(tok0 - 3) * NPJ + C_QKV + ch]);
    x2 = bf2f(PJ[(size_t)(tok0 - 2) * NPJ + C_QKV + ch]);
    x1 = bf2f(PJ[(size_t)(tok0 - 1) * NPJ + C_QKV + ch]);
  }
#pragma unroll
  for (int sg = 0; sg < 8; ++sg) {
    if (isS) {
      const float* st = P.in[6] + ((size_t)(l * 128 + (chunk - 256) * 8 + sg) * 3) * 1536 + ch;
      x3 = st[0]; x2 = st[1536]; x1 = st[2 * 1536];
    }
#pragma unroll
    for (int tt = 0; tt < 8; ++tt) {
      const int t = sg * 8 + tt;
      const float x = bf2f(PJ[(size_t)(tok0 + t) * NPJ + C_QKV + ch]);
      v[t] = siluf(w0 * x3 + w1 * x2 + w2 * x1 + w3 * x);
      x3 = x2; x2 = x1; x1 = x;
    }
  }
}

DI void gdn1_task(const Params& P, int l, int chunk, int head, char* smem) {
  bfu* qn_b = (bfu*)smem;
  bfu* kn_b = qn_b + 64 * 136;
  float* L_s = (float*)(kn_b + 64 * 136);
  float* rq = L_s + 4096;
  float* rk = rq + 64;
  float* sbeta = rk + 64;
  float* sg_ = sbeta + 64;
  float* gcs = sg_ + 64;
  float* eg = gcs + 64;
  float* gl = eg + 64;
  const int tid = otid(), lane = tid & 63, wid = tid >> 6;
  const bfu* PJ = (const bfu*)(P.ws + WS_PROJ);
  const int tok0 = chunk * 64;
  const bool isS = chunk >= 256;
  float v[64];
  gdn_conv_col(P, l, chunk, (tid < 128) ? (head * 128 + tid) : (512 + head * 128 + (tid - 128)), v);
  {
    bfu* dstb = (tid < 128) ? (qn_b + tid) : (kn_b + (tid - 128));
#pragma unroll
    for (int t = 0; t < 64; ++t) dstb[t * 136] = f2bf(v[t]);
  }
  if (tid < 64) {
    const float* AB = (const float*)(P.ws + WS_AB) + (size_t)(tok0 + tid) * 8;
    sbeta[tid] = sigm(AB[4 + head]);
    sg_[tid] = -__expf(P.in[33][l * 4 + head]) * softplusf(AB[head] + P.in[34][l * 4 + head]);
  }
  __syncthreads();
  if (tid < 128) {
    const bfu* rowp = (tid < 64 ? qn_b : kn_b) + (tid & 63) * 136;
    float s = 0.f;
    for (int d = 0; d < 128; ++d) { const float x = bf2f(rowp[d]); s += x * x; }
    if (tid < 64) rq[tid] = rsqrtf(s + 1e-6f) * 0.08838834764831845f;
    else rk[tid - 64] = rsqrtf(s + 1e-6f);
  } else if (tid < 136) {
    const int sg = tid - 128;
    if (isS) {
      float a = 0.f;
      for (int tt = 0; tt < 8; ++tt) { a += sg_[sg * 8 + tt]; gcs[sg * 8 + tt] = a; eg[sg * 8 + tt] = __expf(a); }
      gl[sg] = a;
    } else if (sg == 0) {
      float a = 0.f;
      for (int t = 0; t < 64; ++t) { a += sg_[t]; gcs[t] = a; eg[t] = __expf(a); }
      for (int s2 = 0; s2 < 8; ++s2) gl[s2] = a;
    }
  }
  __syncthreads();
  if (tid < 128) {
    bfu* QG = (bfu*)(P.ws + WS_GQG) + (size_t)tok0 * 512 + head * 128 + tid;
#pragma unroll
    for (int t = 0; t < 64; ++t) QG[(size_t)t * 512] = f2bf(v[t] * rq[t] * eg[t]);
    gdn_conv_col(P, l, chunk, 1024 + head * 128 + tid, v);
  } else {
    bfu* KD = (bfu*)(P.ws + WS_GKD) + (size_t)(chunk * 4 + head) * 8192 + (size_t)(tid - 128) * 64;
#pragma unroll
    for (int t8 = 0; t8 < 8; ++t8) {
      float kd[8];
#pragma unroll
      for (int e = 0; e < 8; ++e) {
        const int t = t8 * 8 + e;
        kd[e] = v[t] * rk[t] * __expf(gl[isS ? t8 : 0] - gcs[t]);
      }
      uint4 pk;
      pk.x = pk2(kd[0], kd[1]); pk.y = pk2(kd[2], kd[3]); pk.z = pk2(kd[4], kd[5]); pk.w = pk2(kd[6], kd[7]);
      *(uint4*)(KD + t8 * 8) = pk;
    }
  }
  {
    bfu* QK = (bfu*)(P.ws + WS_GQK) + (size_t)(chunk * 4 + head) * 4096;
    const int mt = wid >> 1, nt = wid & 1;
    f32x16 KK, QQ;
#pragma unroll
    for (int r = 0; r < 16; ++r) { KK[r] = 0.f; QQ[r] = 0.f; }
#pragma unroll
    for (int ks = 0; ks < 8; ++ks) {
      const bf16x8 ak = *(const bf16x8*)(kn_b + (mt * 32 + (lane & 31)) * 136 + ks * 16 + (lane >> 5) * 8);
      const bf16x8 aq = *(const bf16x8*)(qn_b + (mt * 32 + (lane & 31)) * 136 + ks * 16 + (lane >> 5) * 8);
      const bf16x8 bk = *(const bf16x8*)(kn_b + (nt * 32 + (lane & 31)) * 136 + ks * 16 + (lane >> 5) * 8);
      KK = MFMA32(ak, bk, KK);
      QQ = MFMA32(aq, bk, QQ);
    }
    const int j = nt * 32 + (lane & 31);
    const float gcj = gcs[j], rkj = rk[j];
#pragma unroll
    for (int r = 0; r < 16; ++r) {
      const int i = mt * 32 + rowmap(r, lane);
      const bool ok = (i >= j) && (!isS || ((i >> 3) == (j >> 3)));
      const float dec = ok ? __expf(gcs[i] - gcj) : 0.f;
      L_s[i * 64 + j] = (i > j) ? sbeta[i] * (rk[i] * rkj * KK[r]) * dec : 0.f;
      QK[i * 64 + j] = f2bf(rq[i] * rkj * QQ[r] * dec);
    }
  }
  __syncthreads();
  {
    if (tid < 128) {
#pragma unroll
      for (int t = 0; t < 64; ++t) v[t] *= sbeta[t];
    } else {
#pragma unroll
      for (int t = 0; t < 64; ++t) v[t] *= rk[t] * sbeta[t] * eg[t];
    }
#pragma unroll
    for (int i = 1; i < 64; ++i) {
      float s = v[i];
#pragma unroll
      for (int j4 = 0; j4 <= (i - 1) / 4; ++j4) {
        const float4 lv = *(const float4*)(L_s + i * 64 + j4 * 4);
        s -= lv.x * v[j4 * 4];
        if (j4 * 4 + 1 < i) s -= lv.y * v[j4 * 4 + 1];
        if (j4 * 4 + 2 < i) s -= lv.z * v[j4 * 4 + 2];
        if (j4 * 4 + 3 < i) s -= lv.w * v[j4 * 4 + 3];
      }
      v[i] = s;
    }
    bfu* dst = (bfu*)(P.ws + (tid < 128 ? WS_GU : WS_GW)) + (size_t)tok0 * 512 + head * 128 + (tid & 127);
#pragma unroll
    for (int t = 0; t < 64; ++t) dst[(size_t)t * 512] = f2bf(v[t]);
  }
  if (tid < 8) ((float*)(P.ws + WS_GDEC))[(chunk * 4 + head) * 32 + tid] = __expf(gl[tid]);
  if (isS) {
    for (int idx = tid; idx < 8 * 3 * 384; idx += 256) {
      const int cq = idx % 384, i = (idx / 384) % 3, sg = idx / 1152;
      const int ch = (cq >> 7) * 512 + head * 128 + (cq & 127);
      const int sseq = (chunk - 256) * 8 + sg;
      P.out[O_SGC + ((size_t)(l * 128 + sseq) * 3 + i) * 1536 + ch] = bf2f(PJ[(size_t)(tok0 + sg * 8 + 5 + i) * NPJ + C_QKV + ch]);
    }
  } else if ((chunk & 31) == 31) {
    for (int idx = tid; idx < 3 * 384; idx += 256) {
      const int cq = idx % 384, i = idx / 384;
      const int ch = (cq >> 7) * 512 + head * 128 + (cq & 127);
      P.out[O_PGC + ((size_t)(l * 8 + (chunk >> 5)) * 3 + i) * 1536 + ch] = bf2f(PJ[(size_t)(tok0 + 61 + i) * NPJ + C_QKV + ch]);
    }
  }
}

DI void gdn2_task(const Params& P, int l, int useq, int head, int dvs, char* smem) {
  bfu* Sb = (bfu*)smem;
  bfu* Vn = Sb + 32 * 136;
  const int tid = otid(), lane = tid & 63, w = tid >> 6;
  const bool isS = useq >= 8;
  const int sseq = useq - 8;
  const int nch = isS ? 1 : 32;
  const int chunk0 = isS ? (256 + (sseq >> 3)) : useq * 32;
  const int vseg = isS ? (sseq & 7) : -1;
  const bfu* GW = (const bfu*)(P.ws + WS_GW);
  const bfu* GQ = (const bfu*)(P.ws + WS_GQG);
  const bfu* GU = (const bfu*)(P.ws + WS_GU);
  bfu* PJO = (bfu*)(P.ws + WS_PROJ);
  const bfu* GKD = (const bfu*)(P.ws + WS_GKD);
  const bfu* GQK = (const bfu*)(P.ws + WS_GQK);
  const float* GDEC = (const float*)(P.ws + WS_GDEC);
  const int dv = dvs * 32 + (lane & 31);
  f32x16 S;
  if (isS) {
    const float* s0 = P.in[7] + ((size_t)((l * 128 + sseq) * 4 + head) * 128) * 128 + dv;
#pragma unroll
    for (int r = 0; r < 16; ++r) S[r] = s0[(size_t)(32 * w + rowmap(r, lane)) * 128];
  } else {
#pragma unroll
    for (int r = 0; r < 16; ++r) S[r] = 0.f;
  }
  const bf16x8 zero8 = {0, 0, 0, 0, 0, 0, 0, 0};
  for (int ci = 0; ci < nch; ++ci) {
    const int chunk = chunk0 + ci, tok0 = chunk * 64;
    const int mt = w & 1;
    const int row = mt * 32 + (lane & 31);
    const bool rvalid = !isS || ((row >> 3) == vseg);
    bf16x8 aA[8], aQ[4], aK[4];
    float uu[16];
    {
      const bfu* Ab = (w < 2 ? GW : GQ) + (size_t)(tok0 + row) * 512 + head * 128 + (lane >> 5) * 8;
#pragma unroll
      for (int ks = 0; ks < 8; ++ks) aA[ks] = rvalid ? *(const bf16x8*)(Ab + ks * 16) : zero8;
      const bfu* Kb = GKD + ((size_t)(chunk * 4 + head) * 128 + 32 * w + (lane & 31)) * 64 + (lane >> 5) * 8;
#pragma unroll
      for (int ks = 0; ks < 4; ++ks) {
        const bool gv = !isS || ((ks * 2 + (lane >> 5)) == vseg);
        aK[ks] = gv ? *(const bf16x8*)(Kb + ks * 16) : zero8;
      }
      if (w >= 2) {
        const bfu* Qb = GQK + ((size_t)(chunk * 4 + head) * 64 + row) * 64 + (lane >> 5) * 8;
#pragma unroll
        for (int ks = 0; ks < 4; ++ks) aQ[ks] = rvalid ? *(const bf16x8*)(Qb + ks * 16) : zero8;
#pragma unroll
        for (int r = 0; r < 16; ++r) uu[r] = 0.f;
      } else {
#pragma unroll
        for (int ks = 0; ks < 4; ++ks) aQ[ks] = zero8;
#pragma unroll
        for (int r = 0; r < 16; ++r) {
          const int t = mt * 32 + rowmap(r, lane);
          const bool tv = !isS || ((t >> 3) == vseg);
          uu[r] = tv ? bf2f(GU[(size_t)(tok0 + t) * 512 + head * 128 + dv]) : 0.f;
        }
      }
    }
    const float gdec = GDEC[(chunk * 4 + head) * 32 + (isS ? vseg : 0)];
    __syncthreads();
#pragma unroll
    for (int g4 = 0; g4 < 4; ++g4) {
      uint2 pk;
      pk.x = pk2(S[4 * g4], S[4 * g4 + 1]); pk.y = pk2(S[4 * g4 + 2], S[4 * g4 + 3]);
      *(uint2*)(Sb + (lane & 31) * 136 + 32 * w + 8 * g4 + 4 * (lane >> 5)) = pk;
    }
    __syncthreads();
    f32x16 acc;
#pragma unroll
    for (int r = 0; r < 16; ++r) acc[r] = 0.f;
#pragma unroll
    for (int ks = 0; ks < 8; ++ks) {
      const bf16x8 b8 = *(const bf16x8*)(Sb + (lane & 31) * 136 + ks * 16 + (lane >> 5) * 8);
      acc = MFMA32(aA[ks], b8, acc);
    }
    if (w < 2) {
#pragma unroll
      for (int g4 = 0; g4 < 4; ++g4) {
        uint2 pk;
        pk.x = pk2(uu[4 * g4] - acc[4 * g4], uu[4 * g4 + 1] - acc[4 * g4 + 1]);
        pk.y = pk2(uu[4 * g4 + 2] - acc[4 * g4 + 2], uu[4 * g4 + 3] - acc[4 * g4 + 3]);
        *(uint2*)(Vn + (lane & 31) * 72 + mt * 32 + 8 * g4 + 4 * (lane >> 5)) = pk;
      }
    }
    __syncthreads();
    if (w >= 2) {
#pragma unroll
      for (int ks = 0; ks < 4; ++ks) {
        const bf16x8 b8 = *(const bf16x8*)(Vn + (lane & 31) * 72 + ks * 16 + (lane >> 5) * 8);
        acc = MFMA32(aQ[ks], b8, acc);
      }
#pragma unroll
      for (int r = 0; r < 16; ++r) {
        const int t = mt * 32 + rowmap(r, lane);
        const bool tv = !isS || ((t >> 3) == vseg);
        if (tv) PJO[(size_t)(tok0 + t) * NPJ + C_QKV + (head * 4 + dvs) * 64 + (lane & 31)] = f2bf(acc[r]);
      }
    }
    {
#pragma unroll
      for (int r = 0; r < 16; ++r) S[r] *= gdec;
#pragma unroll
      for (int ks = 0; ks < 4; ++ks) {
        const bf16x8 b8 = *(const bf16x8*)(Vn + (lane & 31) * 72 + ks * 16 + (lane >> 5) * 8);
        S = MFMA32(aK[ks], b8, S);
      }
    }
  }
  float* so = P.out + (isS ? (O_SGS + ((size_t)((l * 128 + sseq) * 4 + head) * 128) * 128)
                           : (O_PGS + ((size_t)((l * 8 + useq) * 4 + head) * 128) * 128)) + dv;
#pragma unroll
  for (int r = 0; r < 16; ++r) so[(size_t)(32 * w + rowmap(r, lane)) * 128] = S[r];
}

DI void gdn3_pass(const Params& P, int l) {
  const int tid_ = otid(), lane = tid_ & 63, wid = tid_ >> 6;
  const bool bal = (gridDim.x == 512), freeb = bal && (blockIdx.x >= 272);
  const int nw = bal ? (freeb ? 960 : 1088) : (int)gridDim.x * 4;
  const int gw = (freeb ? ((int)blockIdx.x - 272) : (int)blockIdx.x) * 4 + wid;
  const int r0 = (bal && !freeb) ? 13056 : 0, r1 = freeb ? 13056 : T_ALL;
  const bfu* GU = (const bfu*)(P.ws + WS_GU);
  bfu* PJ = (bfu*)(P.ws + WS_PROJ);
  const float* nwt = P.in[35] + l * 128 + (lane & 15) * 8;
  for (int r = r0 + gw; r < r1; r += nw) {
    const uint4 ov = *(const uint4*)(PJ + (size_t)r * NPJ + C_QKV + (lane >> 2) * 64 + (lane & 3) * 8);
    const uint4 zv = *(const uint4*)(PJ + (size_t)r * NPJ + C_Z + lane * 8);
    float o[8], z[8];
    const unsigned ow[4] = {ov.x, ov.y, ov.z, ov.w}, zw[4] = {zv.x, zv.y, zv.z, zv.w};
    float ss = 0.f;
#pragma unroll
    for (int e = 0; e < 4; ++e) {
      o[2 * e] = __uint_as_float(ow[e] << 16); o[2 * e + 1] = __uint_as_float(ow[e] & 0xffff0000u);
      z[2 * e] = __uint_as_float(zw[e] << 16); z[2 * e + 1] = __uint_as_float(zw[e] & 0xffff0000u);
      ss += o[2 * e] * o[2 * e] + o[2 * e + 1] * o[2 * e + 1];
    }
    ss += __shfl_xor(ss, 1, 64); ss += __shfl_xor(ss, 2, 64); ss += __shfl_xor(ss, 4, 64); ss += __shfl_xor(ss, 8, 64);
    const float rn = rsqrtf(ss * (1.f / 128.f) + 1e-6f);
    float res[8];
#pragma unroll
    for (int e = 0; e < 8; ++e) res[e] = o[e] * rn * nwt[e] * siluf(z[e]);
    uint4 pk;
    pk.x = pk2(res[0], res[1]); pk.y = pk2(res[2], res[3]); pk.z = pk2(res[4], res[5]); pk.w = pk2(res[6], res[7]);
    *(uint4*)(PJ + (size_t)r * NPJ + C_Z + lane * 8) = pk;
  }
}

DI void phase_mix1a(const Params& P, int l, char* smem) {
  for (int t = blockIdx.x; t < 1088; t += gridDim.x) {
    __syncthreads();
    gdn1_task(P, l, t >> 2, t & 3, smem);
  }
}
DI void phase_mix1b(const Params& P, int l, char* smem) {
  const int NT = 2048 + 8192;
  for (int t = blockIdx.x; t < NT; t += gridDim.x) {
    __syncthreads();
    if (t < 2048) rg_task(P, l, t >> 3, t & 7, 0, smem);
    else { const int r = t - 2048; s5_task(P, l, r >> 5, r & 31, 0, smem); }
  }
}

DI void phase_mix2(const Params& P, int l, char* smem) {
  const int G = gridDim.x;
  for (int t = blockIdx.x; t < 128; t += G) {
    __syncthreads();
    gdn2_task(P, l, t >> 4, (t >> 2) & 3, t & 3, smem);
  }
  unsigned* ctr = (unsigned*)(P.ws + WS_BAR) + XB_WORDS + 64 * (1 + l);
  volatile int* nxt = (volatile int*)(smem + LDS_BYTES - 16);
  const int NR = 2176 + 2176 + 2048;
  for (;;) {
    __syncthreads();
    if (threadIdx.x == 0) *nxt = (int)__hip_atomic_fetch_add(ctr, 1u, __ATOMIC_RELAXED, __HIP_MEMORY_SCOPE_AGENT);
    __syncthreads();
    const int r = *nxt;
    if (r >= NR) break;
    __syncthreads();
    if (r < 2176) {
#pragma unroll 1
      for (int gg = 0; gg < 4; ++gg) { if (gg) __syncthreads(); s5_task(P, l, r >> 3, (r & 7) * 4 + gg, 1, smem); }
    } else if (r < 4352) { const int q = r - 2176; rg_task(P, l, q >> 3, q & 7, 1, smem); }
    else { const int q = r - 4352; gdn2_task(P, l, 8 + (q >> 4), (q >> 2) & 3, q & 3, smem); }
  }
}

__global__ void __launch_bounds__(256, 2) mega_kernel(Params P) {
  extern __shared__ __attribute__((aligned(16))) char smem[];
  cg::grid_group grid = cg::this_grid();
  char* ws = P.ws;
  if (P.out == nullptr) grid.sync();
  GBar gb;
  gbar_init(gb, (unsigned*)(ws + WS_BAR));
  prep_layer(P, 0, smem);
  norm_pass(P, 0, 0, smem);
  gsync(gb);
#pragma unroll 1
  for (int l = 0; l < 2; ++l) {
    gemm_plain((const bfu*)(ws + WS_H), 1024, (const bfu*)(ws + WS_WIN), 1024, 1024, 3584, (bfu*)(ws + WS_PROJ), NPJ, smem);
    gsync(gb);
    phase_mix1b(P, l, smem);
    gsync(gb);
    phase_mix1a(P, l, smem);
    gsync(gb);
    phase_mix2(P, l, smem);
    gsync(gb);
    gemm_glu(P, l, smem);
    gdn3_pass(P, l);
    gsync(gb);
    gemm_merge(P, smem);
    gsync(gb);
    gemm_plain((const bfu*)(ws + WS_MIXED), 1024, (const bfu*)(ws + WS_WOUT), 1024, 1024, 1024, (bfu*)(ws + WS_MO), 1024, smem);
    gsync(gb);
    norm_pass(P, l, 1, smem);
    gsync(gb);
    gemm_ffn1(P, smem);
    gsync(gb);
    gemm_plain((const bfu*)(ws + WS_ACT), 2816, (const bfu*)(ws + WS_WDN), 2816, 2816, 1024, (bfu*)(ws + WS_FO), 1024, smem);
    gsync(gb);
    norm_pass(P, l, 2, smem);
    if (l == 0) prep_layer(P, 1, smem);
    gsync(gb);
  }
}

extern "C" void kernel_launch(void* const* d_in, const int* in_sizes, int n_in, void* d_out, int out_size, void* d_ws, size_t ws_size,
                              hipStream_t stream) {
  static int grid_blocks = 0;
  if (!grid_blocks) {
    int dev = 0, cus = 0, per_cu = 0;
    hipGetDevice(&dev);
    hipDeviceGetAttribute(&cus, hipDeviceAttributeMultiprocessorCount, dev);
    hipFuncSetAttribute((const void*)mega_kernel, hipFuncAttributeMaxDynamicSharedMemorySize, LDS_BYTES);
    hipOccupancyMaxActiveBlocksPerMultiprocessor(&per_cu, mega_kernel, 256, LDS_BYTES);
    if (per_cu > 2) per_cu = 2;
    if (per_cu < 1) per_cu = 1;
    grid_blocks = cus * per_cu;
    grid_blocks &= ~7;
  }
  if (ws_size < WS_END) { fprintf(stderr, "workspace too small: %zu < %zu\n", ws_size, (size_t)WS_END); return; }
  Params p{};
  for (int i = 0; i < 41; ++i) p.in[i] = (const float*)d_in[i];
  p.out = (float*)d_out;
  p.ws = (char*)d_ws;
  hipMemsetAsync((char*)d_ws + WS_BAR, 0, 16384, stream);
  void* args[] = {&p};
  hipError_t e = hipLaunchCooperativeKernel((const void*)mega_kernel, dim3(grid_blocks), dim3(256), args, LDS_BYTES, stream);
  if (e != hipSuccess) fprintf(stderr, "cooperative launch failed: %s (grid %d)\n", hipGetErrorString(e), grid_blocks);
}
```

```cpp
#include <hip/hip_runtime.h>
#include <hip/hip_cooperative_groups.h>
#include <cstdio>
namespace cg = cooperative_groups;

typedef unsigned short bfu;
using bf16x8 = __attribute__((ext_vector_type(8))) short;
using f32x16 = __attribute__((ext_vector_type(16))) float;
using f32x4  = __attribute__((ext_vector_type(4))) float;
using u32x4  = __attribute__((ext_vector_type(4))) unsigned;
#define DI __device__ __forceinline__
#define MFMA32(a, b, c) __builtin_amdgcn_mfma_f32_32x32x16_bf16((a), (b), (c), 0, 0, 0)
#define MFMA16(a, b, c) __builtin_amdgcn_mfma_f32_16x16x32_bf16((a), (b), (c), 0, 0, 0)

constexpr int T_ALL = 17408, TP = 16384, NPJ = 3584;
constexpr int C_RGX = 0, C_RGG = 512, C_S5U = 1024, C_QKV = 1536, C_Z = 3072;
constexpr int LDS_BYTES = 65536;

constexpr size_t O_PRC = 17825792, O_PRH = O_PRC + 24576, O_PSR = O_PRH + 8192, O_PSI = O_PSR + 32768,
                 O_PGC = O_PSI + 32768, O_PGS = O_PGC + 73728, O_SRC = O_PGS + 1048576, O_SRH = O_SRC + 393216,
                 O_SSR = O_SRH + 131072, O_SSI = O_SSR + 524288, O_SGC = O_SSI + 524288, O_SGS = O_SGC + 1179648;

constexpr size_t WS_WIN = 0;
constexpr size_t WS_RGO = WS_WIN + (size_t)6656 * 1024 * 2;
constexpr size_t WS_S5O = WS_RGO + (size_t)1024 * 512 * 2;
constexpr size_t WS_GDO = WS_S5O + (size_t)1024 * 512 * 2;
constexpr size_t WS_GLU = WS_GDO + (size_t)1024 * 512 * 2;
constexpr size_t WS_WOUT = WS_GLU + (size_t)512 * 512 * 2;
constexpr size_t WS_WGU = WS_WOUT + (size_t)1024 * 1024 * 2;
constexpr size_t WS_WDN = WS_WGU + (size_t)5632 * 1024 * 2;
constexpr size_t WS_RGW = WS_WDN + (size_t)1024 * 2816 * 2;
constexpr size_t WS_S5BB = WS_RGW + (size_t)8 * 128 * 64 * 2;
constexpr size_t WS_S5CC = WS_S5BB + (size_t)65536 * 2;
constexpr size_t WS_S5LAM = WS_S5CC + (size_t)65536 * 2;
constexpr size_t WS_H = WS_S5LAM + (size_t)4096 * 4;
constexpr size_t WS_PROJ = WS_H + (size_t)T_ALL * 1024 * 2;
constexpr size_t WS_GQG = WS_PROJ + (size_t)T_ALL * NPJ * 2;
constexpr size_t WS_GU = WS_GQG + (size_t)T_ALL * 512 * 2;
constexpr size_t WS_GW = WS_GU + (size_t)T_ALL * 512 * 2;
constexpr size_t WS_GKD = WS_GW + (size_t)T_ALL * 512 * 2;
constexpr size_t WS_GQK = WS_GKD + (size_t)272 * 4 * 128 * 64 * 2;
constexpr size_t WS_AB = WS_GQK + (size_t)272 * 4 * 64 * 64 * 2;
constexpr size_t WS_RGSUM = WS_AB + (size_t)T_ALL * 8 * 4;
constexpr size_t WS_S5SUM = WS_RGSUM + (size_t)256 * 512 * 2 * 4;
constexpr size_t WS_GDEC = WS_S5SUM + (size_t)256 * 32 * 64 * 2 * 4;
constexpr size_t WS_BAR = WS_GDEC + (size_t)272 * 4 * 32 * 4;
constexpr size_t WS_END = WS_BAR + 16384;
constexpr size_t WS_MIXED = WS_GQG, WS_MO = WS_PROJ, WS_ACT = WS_PROJ, WS_FO = WS_GQG;

struct Params {
  const float* in[41];
  float* out;
  char* ws;
};

DI int otid() { int t = threadIdx.x; asm volatile("" : "+v"(t)); return t; }
DI bfu f2bf(float x) { unsigned u = __float_as_uint(x); u += 0x7fffu + ((u >> 16) & 1u); return (bfu)(u >> 16); }
DI float bf2f(bfu v) { return __uint_as_float(((unsigned)v) << 16); }
DI unsigned pk2(float a, float b) { return (unsigned)f2bf(a) | ((unsigned)f2bf(b) << 16); }
DI float sigm(float x) { return 1.f / (1.f + __expf(-x)); }
DI float siluf(float x) { return x * sigm(x); }
DI float geluf(float x) { float u = 0.7978845608028654f * (x + 0.044715f * x * x * x); float t = __expf(2.f * u); return 0.5f * x * (2.f - 2.f / (t + 1.f)); }
DI float softplusf(float x) { return fmaxf(x, 0.f) + log1pf(__expf(-fabsf(x))); }
DI float wsum(float v) { for (int o = 32; o > 0; o >>= 1) v += __shfl_xor(v, o, 64); return v; }
DI int rowmap(int reg, int lane) { return (reg & 3) + 8 * (reg >> 2) + 4 * (lane >> 5); }

template <int MT>
DI void gemm_tile(const bfu* __restrict__ A, int lda, const bfu* __restrict__ W, int ldw, int K, f32x16 (&acc)[MT][2], char* smem) {
  constexpr int BM = 64 * MT, LS = 72;
  bfu* As = (bfu*)smem;
  bfu* Ws = As + BM * LS;
  const int tid = otid(), lane = tid & 63, wid = tid >> 6, wm = wid >> 1, wn = wid & 1;
  const int lr = tid >> 3, lc = tid & 7;
  u32x4 ra[2 * MT], rw[4];
  const bfu* Ap = A + (size_t)lr * lda + lc * 8;
  const bfu* Wp = W + (size_t)lr * ldw + lc * 8;
#pragma unroll
  for (int i = 0; i < 2 * MT; ++i) ra[i] = *(const u32x4*)(Ap + (size_t)i * 32 * lda);
#pragma unroll
  for (int i = 0; i < 4; ++i) rw[i] = *(const u32x4*)(Wp + (size_t)i * 32 * ldw);
  const int nk = K >> 6;
  const int arow = wm * 32 * MT + (lane & 31), wrow = wn * 64 + (lane & 31), kof = (lane >> 5) * 8;
  for (int kt = 0; kt < nk; ++kt) {
    __syncthreads();
#pragma unroll
    for (int i = 0; i < 2 * MT; ++i) *(u32x4*)(As + (lr + 32 * i) * LS + lc * 8) = ra[i];
#pragma unroll
    for (int i = 0; i < 4; ++i) *(u32x4*)(Ws + (lr + 32 * i) * LS + lc * 8) = rw[i];
    if (kt + 1 < nk) {
      Ap += 64; Wp += 64;
#pragma unroll
      for (int i = 0; i < 2 * MT; ++i) ra[i] = *(const u32x4*)(Ap + (size_t)i * 32 * lda);
#pragma unroll
      for (int i = 0; i < 4; ++i) rw[i] = *(const u32x4*)(Wp + (size_t)i * 32 * ldw);
    }
    __syncthreads();
#pragma unroll
    for (int ks = 0; ks < 4; ++ks) {
      bf16x8 af[MT], wf[2];
#pragma unroll
      for (int mt = 0; mt < MT; ++mt) af[mt] = *(const bf16x8*)(As + (arow + mt * 32) * LS + ks * 16 + kof);
#pragma unroll
      for (int nt = 0; nt < 2; ++nt) wf[nt] = *(const bf16x8*)(Ws + (wrow + nt * 32) * LS + ks * 16 + kof);
#pragma unroll
      for (int mt = 0; mt < MT; ++mt)
#pragma unroll
        for (int nt = 0; nt < 2; ++nt) acc[mt][nt] = MFMA32(wf[nt], af[mt], acc[mt][nt]);
    }
  }
}

template <int MT>
DI void zero_acc(f32x16 (&acc)[MT][2]) {
#pragma unroll
  for (int mt = 0; mt < MT; ++mt)
#pragma unroll
    for (int nt = 0; nt < 2; ++nt)
#pragma unroll
      for (int r = 0; r < 16; ++r) acc[mt][nt][r] = 0.f;
}

#define XB_SIMPLE 0
#define XB_CNT(j) (64 * (1 + (j)))
#define XB_XSUB(j) (64 * (17 + (j)))
#define XB_XGEN(j) (64 * (33 + (j)))
#define XB_TOP (64 * 49)
#define XB_TOPGEN (64 * 50)
#define XB_WORDS (64 * 51)
struct GBar { unsigned* w; unsigned x, nloc, nx, k; };
DI unsigned xb_ld(unsigned* p) { return __hip_atomic_load(p, __ATOMIC_RELAXED, __HIP_MEMORY_SCOPE_AGENT); }
DI unsigned xb_add(unsigned* p, unsigned v) { return __hip_atomic_fetch_add(p, v, __ATOMIC_RELAXED, __HIP_MEMORY_SCOPE_AGENT); }
DI void gbar_init(GBar& b, unsigned* w) {
  b.w = w; b.k = 0; b.nloc = 1; b.nx = 1;
  b.x = (unsigned)__builtin_amdgcn_s_getreg((3 << 11) | 20) & 0xFu;
  if (threadIdx.x == 0) {
    const unsigned r0 = xb_add(&w[XB_CNT(b.x)], 1u);
    asm volatile("s_waitcnt vmcnt(0)" ::"v"(r0) : "memory");
    xb_add(&w[XB_SIMPLE], 1u);
    while (xb_ld(&w[XB_SIMPLE]) < gridDim.x) __builtin_amdgcn_s_sleep(1);
    unsigned mine = 1u, cnt = 0u;
    for (unsigned j = 0; j < 16; ++j) { const unsigned c = xb_ld(&w[XB_CNT(j)]); cnt += (c > 0u) ? 1u : 0u; mine = (j == b.x) ? c : mine; }
    b.nloc = mine; b.nx = cnt;
  }
  __syncthreads();
}
DI void gsync(GBar& b) {
  asm volatile("s_waitcnt vmcnt(0)" ::: "memory");
  __syncthreads();
  if (threadIdx.x == 0) {
    unsigned* w = b.w;
    const unsigned gen = b.k;
    const unsigned old = xb_add(&w[XB_XSUB(b.x)], 1u);
    if (old + 1u == (gen + 1u) * b.nloc) {
      __builtin_amdgcn_fence(__ATOMIC_RELEASE, "agent");
      asm volatile("s_waitcnt vmcnt(0)" ::: "memory");
      const unsigned og = xb_add(&w[XB_TOP], 1u);
      if (og + 1u == (gen + 1u) * b.nx) xb_add(&w[XB_TOPGEN], 1u);
      else while (xb_ld(&w[XB_TOPGEN]) == gen) __builtin_amdgcn_s_sleep(1);
      __builtin_amdgcn_fence(__ATOMIC_ACQUIRE, "agent");
      xb_add(&w[XB_XGEN(b.x)], 1u);
      asm volatile("s_waitcnt vmcnt(0)" ::: "memory");
    } else {
      while (xb_ld(&w[XB_XGEN(b.x)]) == gen) __builtin_amdgcn_s_sleep(1);
      __builtin_amdgcn_fence(__ATOMIC_ACQUIRE, "agent");
      asm volatile("s_waitcnt vmcnt(0)" ::: "memory");
    }
  }
  b.k += 1;
  __syncthreads();
}

DI bool tile_map(int it, int nM, int nN, int& tm, int& tn) {
  const int ntiles = nM * nN, per = (ntiles + 7) >> 3;
  const int xcd = blockIdx.x & 7, local = (blockIdx.x >> 3) + it * (gridDim.x >> 3);
  if (local >= per) return false;
  const int q = xcd * per + local;
  if (q >= ntiles) return false;
  const int grp = q / (8 * nN), fm = grp * 8, gsz = min(nM - fm, 8), within = q - grp * 8 * nN;
  tm = fm + within % gsz; tn = within / gsz;
  return true;
}

DI void tile_of(int q, int nM, int nN, int& tm, int& tn) {
  const int grp = q / (8 * nN), fm = grp * 8, gsz = min(nM - fm, 8), within = q - grp * 8 * nN;
  tm = fm + within % gsz; tn = within / gsz;
}
template <int MT>
DI void plain_tile(const bfu* A, int lda, const bfu* W, int ldw, int K, bfu* C, int ldc, int m0, int n0, char* smem) {
  const int tid_ = otid(), lane = tid_ & 63, wid = tid_ >> 6, wm = wid >> 1, wn = wid & 1;
  f32x16 acc[MT][2];
  zero_acc<MT>(acc);
  gemm_tile<MT>(A + (size_t)m0 * lda, lda, W + (size_t)n0 * ldw, ldw, K, acc, smem);
  __syncthreads();
  {
    char* cs = smem;
#pragma unroll
    for (int mt = 0; mt < MT; ++mt) {
      const int m = wm * 32 * MT + mt * 32 + (lane & 31), sw = m & 31;
#pragma unroll
      for (int nt = 0; nt < 2; ++nt)
#pragma unroll
        for (int g4 = 0; g4 < 4; ++g4) {
          const int c8 = (wn * 64 + nt * 32 + 8 * g4 + 4 * (lane >> 5)) >> 2;
          uint2 pk;
          pk.x = pk2(acc[mt][nt][4 * g4], acc[mt][nt][4 * g4 + 1]);
          pk.y = pk2(acc[mt][nt][4 * g4 + 2], acc[mt][nt][4 * g4 + 3]);
          *(uint2*)(cs + m * 256 + ((c8 ^ sw) << 3)) = pk;
        }
    }
  }
  __syncthreads();
  {
    const char* cs = smem;
    const int jj = tid_ & 15;
#pragma unroll
    for (int i = 0; i < 4 * MT; ++i) {
      const int row = (tid_ >> 4) + 16 * i, sw = row & 31;
      uint4 v = *(const uint4*)(cs + row * 256 + ((jj ^ (sw >> 1)) << 4));
      if (sw & 1) { const unsigned t0 = v.x, t1 = v.y; v.x = v.z; v.y = v.w; v.z = t0; v.w = t1; }
      *(uint4*)(C + (size_t)(m0 + row) * ldc + n0 + jj * 8) = v;
    }
  }
}
DI void gemm_plain(const bfu* A, int lda, const bfu* W, int ldw, int K, int N, bfu* C, int ldc, char* smem) {
  const int nM = T_ALL / 256, nN = N / 128, ntiles = nM * nN, G = gridDim.x;
  const int rem = ntiles % G;
  const bool split = (rem > 0) && (rem * 4 <= G) && ((G & 7) == 0);
  if (!split) {
    for (int it = 0;; ++it) {
      int tm, tn;
      if (!tile_map(it, nM, nN, tm, tn)) break;
      plain_tile<4>(A, lda, W, ldw, K, C, ldc, tm * 256, tn * 128, smem);
    }
    return;
  }
  const int nfull = ntiles - rem, per = nfull >> 3;
  const int xcd = blockIdx.x & 7, slots = G >> 3;
  for (int local = blockIdx.x >> 3; local < per; local += slots) {
    int tm, tn;
    tile_of(xcd * per + local, nM, nN, tm, tn);
    plain_tile<4>(A, lda, W, ldw, K, C, ldc, tm * 256, tn * 128, smem);
  }
  for (int sidx = blockIdx.x; sidx < rem * 4; sidx += G) {
    int tm, tn;
    tile_of(nfull + (sidx >> 2), nM, nN, tm, tn);
    plain_tile<1>(A, lda, W, ldw, K, C, ldc, tm * 256 + (sidx & 3) * 64, tn * 128, smem);
  }
}

DI void gemm_glu(const Params& P, int l, char* smem) {
  bfu* PJ = (bfu*)(P.ws + WS_PROJ);
  const bfu* W = (const bfu*)(P.ws + WS_GLU);
  const float* gb = P.in[30] + l * 512;
  const int nM = T_ALL / 256, nN = 4;
  const int tid_ = otid(), lane = tid_ & 63, wid = tid_ >> 6, wm = wid >> 1, wn = wid & 1;
  for (int it = 0;; ++it) {
    int tm, tn;
    if (!tile_map(it, nM, nN, tm, tn)) break;
    f32x16 acc[4][2];
    zero_acc<4>(acc);
    gemm_tile<4>(PJ + (size_t)tm * 256 * NPJ + C_S5U, NPJ, W + (size_t)tn * 128 * 512, 512, 512, acc, smem);
#pragma unroll
    for (int mt = 0; mt < 4; ++mt) {
      const int m = tm * 256 + wm * 128 + mt * 32 + (lane & 31);
#pragma unroll
      for (int nt = 0; nt < 2; ++nt)
#pragma unroll
        for (int g4 = 0; g4 < 4; ++g4) {
          const int n = tn * 128 + wn * 64 + nt * 32 + 8 * g4 + 4 * (lane >> 5);
          const uint2 yv = *(const uint2*)(PJ + (size_t)m * NPJ + C_S5U + n);
          const float4 bv = *(const float4*)(gb + n);
          const float y0 = bf2f((bfu)(yv.x & 0xffff)), y1 = bf2f((bfu)(yv.x >> 16)), y2 = bf2f((bfu)(yv.y & 0xffff)), y3 = bf2f((bfu)(yv.y >> 16));
          uint2 pk;
          pk.x = pk2(y0 * sigm(acc[mt][nt][4 * g4] + bv.x), y1 * sigm(acc[mt][nt][4 * g4 + 1] + bv.y));
          pk.y = pk2(y2 * sigm(acc[mt][nt][4 * g4 + 2] + bv.z), y3 * sigm(acc[mt][nt][4 * g4 + 3] + bv.w));
          *(uint2*)(PJ + (size_t)m * NPJ + C_RGX + n) = pk;
        }
    }
  }
}

DI void gemm_ffn1(const Params& P, char* smem) {
  const bfu* A = (const bfu*)(P.ws + WS_H);
  const bfu* W = (const bfu*)(P.ws + WS_WGU);
  bfu* C = (bfu*)(P.ws + WS_ACT);
  const int nM = T_ALL / 256, nN = 44;
  const int tid_ = otid(), lane = tid_ & 63, wid = tid_ >> 6, wm = wid >> 1, wn = wid & 1;
  for (int it = 0;; ++it) {
    int tm, tn;
    if (!tile_map(it, nM, nN, tm, tn)) break;
    f32x16 acc[4][2];
    zero_acc<4>(acc);
    gemm_tile<4>(A + (size_t)tm * 256 * 1024, 1024, W + (size_t)tn * 128 * 1024, 1024, 1024, acc, smem);
#pragma unroll
    for (int mt = 0; mt < 4; ++mt) {
      const int m = tm * 256 + wm * 128 + mt * 32 + (lane & 31);
#pragma unroll
      for (int g4 = 0; g4 < 4; ++g4) {
        const int j = tn * 64 + wn * 32 + 8 * g4 + 4 * (lane >> 5);
        uint2 pk;
        pk.x = pk2(siluf(acc[mt][0][4 * g4]) * acc[mt][1][4 * g4], siluf(acc[mt][0][4 * g4 + 1]) * acc[mt][1][4 * g4 + 1]);
        pk.y = pk2(siluf(acc[mt][0][4 * g4 + 2]) * acc[mt][1][4 * g4 + 2], siluf(acc[mt][0][4 * g4 + 3]) * acc[mt][1][4 * g4 + 3]);
        *(uint2*)(C + (size_t)m * 2816 + j) = pk;
      }
    }
  }
}

template <int MT>
DI void merge_tile(const Params& P, int m0, int tn, char* smem) {
  const bfu* H = (const bfu*)(P.ws + WS_H);
  const bfu* PJ = (const bfu*)(P.ws + WS_PROJ);
  const bfu* WIN = (const bfu*)(P.ws + WS_WIN);
  bfu* C = (bfu*)(P.ws + WS_MIXED);
  const int tid_ = otid(), lane = tid_ & 63, wid = tid_ >> 6, wm = wid >> 1, wn = wid & 1;
  f32x16 tot[MT][2];
  zero_acc<MT>(tot);
#pragma unroll 1
  for (int b = 0; b < 3; ++b) {
    unsigned* gps = (unsigned*)(smem + 36864) + tid_;
    unsigned gkeep[4] = {0u, 0u, 0u, 0u};
    {
      f32x16 g[MT][2];
      zero_acc<MT>(g);
      gemm_tile<MT>(H + (size_t)m0 * 1024, 1024, WIN + (size_t)(3584 + b * 1024 + tn * 128) * 1024, 1024, 1024, g, smem);
#pragma unroll
      for (int mt = 0; mt < MT; ++mt)
#pragma unroll
        for (int nt = 0; nt < 2; ++nt)
#pragma unroll
          for (int r = 0; r < 8; ++r) {
            const unsigned pv = pk2(sigm(g[mt][nt][2 * r]), sigm(g[mt][nt][2 * r + 1]));
            if ((mt * 2 + nt) * 8 + r < 28) gps[((mt * 2 + nt) * 8 + r) * 256] = pv;
            else gkeep[((mt * 2 + nt) * 8 + r) - 28] = pv;
          }
    }
    const int colb = (b == 0) ? C_RGG : (b == 1 ? C_RGX : C_Z);
    const bfu* Wo = (const bfu*)(P.ws + (b == 0 ? WS_RGO : (b == 1 ? WS_S5O : WS_GDO)));
    f32x16 y[MT][2];
    zero_acc<MT>(y);
    gemm_tile<MT>(PJ + (size_t)m0 * NPJ + colb, NPJ, Wo + (size_t)tn * 128 * 512, 512, 512, y, smem);
#pragma unroll
    for (int mt = 0; mt < MT; ++mt)
#pragma unroll
      for (int nt = 0; nt < 2; ++nt)
#pragma unroll
        for (int r = 0; r < 8; ++r) {
          const unsigned gv = ((mt * 2 + nt) * 8 + r < 28) ? gps[((mt * 2 + nt) * 8 + r) * 256] : gkeep[((mt * 2 + nt) * 8 + r) - 28];
          tot[mt][nt][2 * r] += __uint_as_float(gv << 16) * y[mt][nt][2 * r];
          tot[mt][nt][2 * r + 1] += __uint_as_float(gv & 0xffff0000u) * y[mt][nt][2 * r + 1];
        }
  }
#pragma unroll
  for (int mt = 0; mt < MT; ++mt) {
    const int m = m0 + wm * 32 * MT + mt * 32 + (lane & 31);
#pragma unroll
    for (int nt = 0; nt < 2; ++nt)
#pragma unroll
      for (int g4 = 0; g4 < 4; ++g4) {
        const int n = tn * 128 + wn * 64 + nt * 32 + 8 * g4 + 4 * (lane >> 5);
        uint2 pk;
        pk.x = pk2(tot[mt][nt][4 * g4], tot[mt][nt][4 * g4 + 1]);
        pk.y = pk2(tot[mt][nt][4 * g4 + 2], tot[mt][nt][4 * g4 + 3]);
        *(uint2*)(C + (size_t)m * 1024 + n) = pk;
      }
  }
}
DI void gemm_merge(const Params& P, char* smem) {
  const int nM = T_ALL / 128, nN = 8, ntiles = nM * nN, G = gridDim.x;
  const int rem = ntiles % G;
  const bool split = (rem > 0) && (rem * 2 <= G / 2) && ((G & 7) == 0);
  if (!split) {
    for (int it = 0;; ++it) {
      int tm, tn;
      if (!tile_map(it, nM, nN, tm, tn)) break;
      merge_tile<2>(P, tm * 128, tn, smem);
    }
    return;
  }
  const int nfull = ntiles - rem, per = nfull >> 3;
  const int xcd = blockIdx.x & 7, slots = G >> 3;
  for (int local = blockIdx.x >> 3; local < per; local += slots) {
    int tm, tn;
    tile_of(xcd * per + local, nM, nN, tm, tn);
    merge_tile<2>(P, tm * 128, tn, smem);
  }
  for (int sidx = blockIdx.x; sidx < rem * 2; sidx += G) {
    int tm, tn;
    tile_of(nfull + (sidx >> 1), nM, nN, tm, tn);
    merge_tile<1>(P, tm * 128 + (sidx & 1) * 64, tn, smem);
  }
}

DI void cvt_job(const float* src, int ld, int K, int ncols, bfu* dst, int ldd, int mode, float* sm) {
  const int nkt = K >> 6, nnt = ncols >> 6, nt = nkt * nnt;
  const int tid = otid();
  for (int t = blockIdx.x; t < nt; t += gridDim.x) {
    const int kt = t % nkt, ct = t / nkt;
    const int k0 = kt * 64, c0 = ct * 64;
    float4 v[4];
#pragma unroll
    for (int i = 0; i < 4; ++i) v[i] = *(const float4*)(src + (size_t)(k0 + (tid >> 4) + 16 * i) * ld + c0 + (tid & 15) * 4);
    __syncthreads();
#pragma unroll
    for (int i = 0; i < 4; ++i) {
      const int k = (tid >> 4) + 16 * i, n = (tid & 15) * 4;
      sm[(n + 0) * 65 + k] = v[i].x; sm[(n + 1) * 65 + k] = v[i].y; sm[(n + 2) * 65 + k] = v[i].z; sm[(n + 3) * 65 + k] = v[i].w;
    }
    __syncthreads();
    const int n = tid >> 2, ks = (tid & 3) * 16;
    const int row = (mode == 0) ? (c0 + n) : (ct * 128 + (n >> 5) * 64 + (mode - 1) * 32 + (n & 31));
    uint4 w0, w1;
    const float* r = sm + n * 65 + ks;
    w0.x = pk2(r[0], r[1]); w0.y = pk2(r[2], r[3]); w0.z = pk2(r[4], r[5]); w0.w = pk2(r[6], r[7]);
    w1.x = pk2(r[8], r[9]); w1.y = pk2(r[10], r[11]); w1.z = pk2(r[12], r[13]); w1.w = pk2(r[14], r[15]);
    *(uint4*)(dst + (size_t)row * ldd + k0 + ks) = w0;
    *(uint4*)(dst + (size_t)row * ldd + k0 + ks + 8) = w1;
  }
}

DI void prep_layer(const Params& P, int l, char* smem) {
  float* sm = (float*)smem;
  char* ws = P.ws;
  cvt_job(P.in[12] + (size_t)l * 1024 * 6664, 6664, 1024, 3584, (bfu*)(ws + WS_WIN), 1024, 0, sm);
  cvt_job(P.in[12] + (size_t)l * 1024 * 6664 + 3592, 6664, 1024, 3072, (bfu*)(ws + WS_WIN) + (size_t)3584 * 1024, 1024, 0, sm);
  cvt_job(P.in[20] + (size_t)l * 512 * 1024, 1024, 512, 1024, (bfu*)(ws + WS_RGO), 512, 0, sm);
  cvt_job(P.in[31] + (size_t)l * 512 * 1024, 1024, 512, 1024, (bfu*)(ws + WS_S5O), 512, 0, sm);
  cvt_job(P.in[36] + (size_t)l * 512 * 1024, 1024, 512, 1024, (bfu*)(ws + WS_GDO), 512, 0, sm);
  cvt_job(P.in[29] + (size_t)l * 512 * 512, 512, 512, 512, (bfu*)(ws + WS_GLU), 512, 0, sm);
  cvt_job(P.in[37] + (size_t)l * 1024 * 1024, 1024, 1024, 1024, (bfu*)(ws + WS_WOUT), 1024, 0, sm);
  cvt_job(P.in[38] + (size_t)l * 1024 * 2816, 2816, 1024, 2816, (bfu*)(ws + WS_WGU), 1024, 1, sm);
  cvt_job(P.in[39] + (size_t)l * 1024 * 2816, 2816, 1024, 2816, (bfu*)(ws + WS_WGU), 1024, 2, sm);
  cvt_job(P.in[40] + (size_t)l * 2816 * 1024, 1024, 2816, 1024, (bfu*)(ws + WS_WDN), 2816, 0, sm);
#pragma unroll 1
  for (int n = 0; n < 8; ++n) {
    cvt_job(P.in[15] + (size_t)(l * 8 + n) * 4096, 64, 64, 64, (bfu*)(ws + WS_RGW) + (size_t)n * 8192, 64, 0, sm);
    cvt_job(P.in[17] + (size_t)(l * 8 + n) * 4096, 64, 64, 64, (bfu*)(ws + WS_RGW) + (size_t)n * 8192 + 4096, 64, 0, sm);
  }
  bfu* BB = (bfu*)(ws + WS_S5BB);
  bfu* CC = (bfu*)(ws + WS_S5CC);
  float* LAM = (float*)(ws + WS_S5LAM);
  for (int idx = blockIdx.x * 256 + otid(); idx < 2048; idx += gridDim.x * 256) {
    const int g = idx >> 6, p = idx & 63;
    const float ar = P.in[21][l * 2048 + idx], ai = P.in[22][l * 2048 + idx];
    const float dt = expf(P.in[28][l * 32 + g]);
    const float mag = expf(ar * dt), ang = ai * dt;
    const float lr = mag * cosf(ang), li = mag * sinf(ang);
    LAM[idx * 2] = lr; LAM[idx * 2 + 1] = li;
    const float den = 1.f / (ar * ar + ai * ai);
    const float cr = ((lr - 1.f) * ar + li * ai) * den, ci = (li * ar - (lr - 1.f) * ai) * den;
    const float* bre = P.in[23] + ((size_t)(l * 32 + g) * 64 + p) * 16;
    const float* bim = P.in[24] + ((size_t)(l * 32 + g) * 64 + p) * 16;
    for (int h = 0; h < 16; ++h) {
      const float br = bre[h], bi = bim[h];
      BB[(size_t)(g * 128 + p) * 16 + h] = f2bf(cr * br - ci * bi);
      BB[(size_t)(g * 128 + 64 + p) * 16 + h] = f2bf(cr * bi + ci * br);
      CC[(size_t)(g * 16 + h) * 128 + p] = f2bf(P.in[25][((size_t)(l * 32 + g) * 16 + h) * 64 + p]);
      CC[(size_t)(g * 16 + h) * 128 + 64 + p] = f2bf(-P.in[26][((size_t)(l * 32 + g) * 16 + h) * 64 + p]);
    }
  }
}

DI void norm_pass(const Params& P, int l, int mode, char* smem) {
  const int tid_ = otid(), lane = tid_ & 63, wid = tid_ >> 6;
  const int nw = gridDim.x * 4, gw = blockIdx.x * 4 + wid;
  const bfu* src = (const bfu*)(P.ws + (mode == 1 ? WS_MO : WS_FO));
  const float* gA = (mode == 1 ? P.in[9] : P.in[11]) + l * 1024;
  const bool doH = (mode != 2) || (l == 0);
  const float* gB = (mode == 0) ? P.in[8] : (mode == 1 ? P.in[10] + l * 1024 : P.in[8] + 1024);
  const bool doAB = (mode == 0) || (mode == 2 && l == 0);
  const int lab = (mode == 0) ? 0 : 1;
  const float* W8 = P.in[12] + (size_t)lab * 1024 * 6664 + 3584;
  bfu* H = (bfu*)(P.ws + WS_H);
  float* AB = (float*)(P.ws + WS_AB);
  float* W8s = (float*)smem;
  if (doAB) {
    __syncthreads();
    for (int idx = tid_; idx < 8192; idx += 256) W8s[(idx & 7) * 1024 + (idx >> 3)] = W8[(size_t)(idx >> 3) * 6664 + (idx & 7)];
    __syncthreads();
  }
  for (int r = gw; r < T_ALL; r += nw) {
    float4 xv[4];
    float* xo = P.out + (size_t)r * 1024;
    if (mode == 0) {
      const float* xi = (r < TP) ? (P.in[0] + (size_t)r * 1024) : (P.in[1] + (size_t)(r - TP) * 1024);
#pragma unroll
      for (int i = 0; i < 4; ++i) xv[i] = *(const float4*)(xi + lane * 4 + 256 * i);
    } else {
      float4 av[4];
      float ss = 0.f;
#pragma unroll
      for (int i = 0; i < 4; ++i) {
        xv[i] = *(const float4*)(xo + lane * 4 + 256 * i);
        const uint2 s2 = *(const uint2*)(src + (size_t)r * 1024 + lane * 4 + 256 * i);
        av[i].x = bf2f((bfu)(s2.x & 0xffff)); av[i].y = bf2f((bfu)(s2.x >> 16));
        av[i].z = bf2f((bfu)(s2.y & 0xffff)); av[i].w = bf2f((bfu)(s2.y >> 16));
        ss += av[i].x * av[i].x + av[i].y * av[i].y + av[i].z * av[i].z + av[i].w * av[i].w;
      }
      ss = wsum(ss);
      const float sa = rsqrtf(ss * (1.f / 1024.f) + 1e-6f);
#pragma unroll
      for (int i = 0; i < 4; ++i) {
        const float4 gv = *(const float4*)(gA + lane * 4 + 256 * i);
        xv[i].x += av[i].x * sa * gv.x; xv[i].y += av[i].y * sa * gv.y;
        xv[i].z += av[i].z * sa * gv.z; xv[i].w += av[i].w * sa * gv.w;
      }
    }
#pragma unroll
    for (int i = 0; i < 4; ++i) *(float4*)(xo + lane * 4 + 256 * i) = xv[i];
    if (doH) {
      float ss = 0.f;
#pragma unroll
      for (int i = 0; i < 4; ++i) ss += xv[i].x * xv[i].x + xv[i].y * xv[i].y + xv[i].z * xv[i].z + xv[i].w * xv[i].w;
      ss = wsum(ss);
      const float sc = rsqrtf(ss * (1.f / 1024.f) + 1e-6f);
      float ab[8];
#pragma unroll
      for (int j = 0; j < 8; ++j) ab[j] = 0.f;
#pragma unroll
      for (int i = 0; i < 4; ++i) {
        const float4 gv = *(const float4*)(gB + lane * 4 + 256 * i);
        float hv[4] = {xv[i].x * sc * gv.x, xv[i].y * sc * gv.y, xv[i].z * sc * gv.z, xv[i].w * sc * gv.w};
        uint2 pk;
        pk.x = pk2(hv[0], hv[1]); pk.y = pk2(hv[2], hv[3]);
        *(uint2*)(H + (size_t)r * 1024 + lane * 4 + 256 * i) = pk;
        if (doAB) {
#pragma unroll
          for (int j = 0; j < 8; ++j) {
            const float4 wj = *(const float4*)(W8s + j * 1024 + lane * 4 + 256 * i);
            ab[j] += hv[0] * wj.x; ab[j] += hv[1] * wj.y; ab[j] += hv[2] * wj.z; ab[j] += hv[3] * wj.w;
          }
        }
      }
      if (doAB) {
#pragma unroll
        for (int j = 0; j < 8; ++j) ab[j] = wsum(ab[j]);
        if (lane == 0) {
          *(float4*)(AB + (size_t)r * 8) = make_float4(ab[0], ab[1], ab[2], ab[3]);
          *(float4*)(AB + (size_t)r * 8 + 4) = make_float4(ab[4], ab[5], ab[6], ab[7]);
        }
      }
    }
  }
}

DI void rg_task(const Params& P, int l, int chunk, int n, int mode, char* smem) {
  float* xc_f = (float*)smem;
  bfu* xc_b = (bfu*)(xc_f + 64 * 65);
  float* a_s = (float*)(xc_b + 64 * 72);
  float* in_s = a_s + 4096;
  float* segP = in_s + 4096;
  float* segH = segP + 512;
  float* car = segH + 512;
  float* part = car + 64;
  const int tid = otid(), lane = tid & 63, wid = tid >> 6;
  bfu* PJ = (bfu*)(P.ws + WS_PROJ);
  const int tok0 = chunk * 64;
  const bool isS = chunk >= 256;
  const int c = tid & 63, tq = tid >> 6, cc = n * 64 + c;
  const bfu* RGW = (const bfu*)(P.ws + WS_RGW) + (size_t)n * 8192;
  bf16x8 wbr[4], wbi[4];
#pragma unroll
  for (int ks = 0; ks < 4; ++ks) {
    wbr[ks] = *(const bf16x8*)(RGW + ((wid & 1) * 32 + (lane & 31)) * 64 + ks * 16 + (lane >> 5) * 8);
    wbi[ks] = *(const bf16x8*)(RGW + (64 + (wid & 1) * 32 + (lane & 31)) * 64 + ks * 16 + (lane >> 5) * 8);
  }
  const int cch0 = n * 64 + (wid & 1) * 32 + (lane & 31);
  const float ba = P.in[16][l * 512 + cch0], bx = P.in[18][l * 512 + cch0];
  const float sp = softplusf(-P.in[19][l * 512 + cch0]);
  float gt2[2][8];
  float2 rprev[8];
  float* RGSUM = (float*)(P.ws + WS_RGSUM);
  if (mode != 0) {
#pragma unroll
    for (int q = 0; q < 2; ++q)
#pragma unroll
      for (int tt = 0; tt < 8; ++tt) gt2[q][tt] = bf2f(PJ[(size_t)(tok0 + (tq + 4 * q) * 8 + tt) * NPJ + C_RGG + cc]);
    if (!isS) {
      const int ci = chunk & 31, cs = chunk & ~31;
#pragma unroll
      for (int i = 0; i < 8; ++i) {
        const int c2 = tq * 8 + i;
        rprev[i] = (c2 < ci) ? *(const float2*)(RGSUM + ((size_t)(cs + c2) * 512 + cc) * 2) : make_float2(1.f, 0.f);
      }
    }
  }
  {
    const float* cw = P.in[13] + l * 2048;
    const float w0 = cw[cc], w1 = cw[512 + cc], w2 = cw[1024 + cc], w3 = cw[1536 + cc], cb = P.in[14][l * 512 + cc];
    if (!isS) {
      bfu* xs = (bfu*)a_s;
      const bool first = (chunk & 31) == 0;
#pragma unroll
      for (int j = 0; j < 3; ++j) {
        const int idx = tid + 256 * j;
        if (idx < 67 * 8) {
          const int row = idx >> 3, ch = idx & 7;
          u32x4 v = {0u, 0u, 0u, 0u};
          if (!(first && row < 3)) v = *(const u32x4*)(PJ + (size_t)(tok0 - 3 + row) * NPJ + C_RGX + n * 64 + ch * 8);
          *(u32x4*)(xs + row * 64 + ch * 8) = v;
        }
      }
      __syncthreads();
#pragma unroll 4
      for (int i = 0; i < 16; ++i) {
        const int t = tq + 4 * i;
        const float acc = cb + w0 * bf2f(xs[t * 64 + c]) + w1 * bf2f(xs[(t + 1) * 64 + c]) + w2 * bf2f(xs[(t + 2) * 64 + c]) + w3 * bf2f(xs[(t + 3) * 64 + c]);
        xc_f[t * 65 + c] = acc;
        xc_b[t * 72 + c] = f2bf(acc);
      }
    } else {
#pragma unroll 4
      for (int i = 0; i < 16; ++i) {
        const int t = tq + 4 * i, tok = tok0 + t, tl = tok & 7;
        float xk[4];
#pragma unroll
        for (int k = 0; k < 4; ++k) {
          const int j = tl + k - 3;
          if (j >= 0) xk[k] = bf2f(PJ[(size_t)(tok + k - 3) * NPJ + C_RGX + cc]);
          else xk[k] = P.in[2][((size_t)(l * 128 + ((tok - TP) >> 3)) * 3 + (tl + k)) * 512 + cc];
        }
        const float acc = cb + w0 * xk[0] + w1 * xk[1] + w2 * xk[2] + w3 * xk[3];
        xc_f[t * 65 + c] = acc;
        xc_b[t * 72 + c] = f2bf(acc);
      }
    }
  }
  __syncthreads();
  {
    const int mt = wid >> 1, ntl = wid & 1;
    f32x16 R, I;
#pragma unroll
    for (int r = 0; r < 16; ++r) { R[r] = 0.f; I[r] = 0.f; }
#pragma unroll
    for (int ks = 0; ks < 4; ++ks) {
      const bf16x8 a = *(const bf16x8*)(xc_b + (mt * 32 + (lane & 31)) * 72 + ks * 16 + (lane >> 5) * 8);
      R = MFMA32(a, wbr[ks], R);
      I = MFMA32(a, wbi[ks], I);
    }
    const int ch = ntl * 32 + (lane & 31);
#pragma unroll
    for (int r = 0; r < 16; ++r) {
      const int t = mt * 32 + rowmap(r, lane);
      const float rr = sigm(R[r] + ba), ig = sigm(I[r] + bx);
      const float la = -8.f * rr * sp;
      const float a = __expf(la);
      const float inp = sqrtf(fmaxf(-expm1f(2.f * la), 0.f)) * ig * xc_f[t * 65 + ch];
      a_s[t * 64 + ch] = a;
      in_s[t * 64 + ch] = inp;
    }
  }
  __syncthreads();
#pragma unroll
  for (int q = 0; q < 2; ++q) {
    const int sg = tq + 4 * q;
    float Pp = 1.f, Hh = 0.f;
#pragma unroll
    for (int tt = 0; tt < 8; ++tt) {
      const float a = a_s[(sg * 8 + tt) * 64 + c];
      Hh = a * Hh + in_s[(sg * 8 + tt) * 64 + c];
      Pp *= a;
    }
    segP[sg * 64 + c] = Pp; segH[sg * 64 + c] = Hh;
  }
  __syncthreads();
  if (mode == 0) {
    if (tid < 64) {
      float Pp = 1.f, Hh = 0.f;
#pragma unroll
      for (int sg = 0; sg < 8; ++sg) { Hh = segP[sg * 64 + c] * Hh + segH[sg * 64 + c]; Pp *= segP[sg * 64 + c]; }
      *(float2*)(RGSUM + ((size_t)chunk * 512 + cc) * 2) = make_float2(Pp, Hh);
    }
    return;
  }
  if (!isS) {
    const int ci = chunk & 31, cs = chunk & ~31;
    float Pp = 1.f, Hh = 0.f;
#pragma unroll
    for (int i = 0; i < 8; ++i) {
      const int c2 = tq * 8 + i;
      if (c2 < ci) {
        const float2 ph = rprev[i];
        Hh = ph.x * Hh + ph.y; Pp *= ph.x;
      }
    }
    part[(tq * 64 + c) * 2] = Pp; part[(tq * 64 + c) * 2 + 1] = Hh;
    __syncthreads();
    if (tid < 64) {
      float h = 0.f;
#pragma unroll
      for (int q2 = 0; q2 < 4; ++q2) h = part[(q2 * 64 + c) * 2] * h + part[(q2 * 64 + c) * 2 + 1];
      car[c] = h;
    }
    __syncthreads();
  }
#pragma unroll
  for (int q = 0; q < 2; ++q) {
    const int sg = tq + 4 * q;
    float h;
    const int sseq = (tok0 - TP) / 8 + sg;
    if (isS) h = P.in[3][(size_t)(l * 128 + sseq) * 512 + cc];
    else {
      h = car[c];
      for (int s2 = 0; s2 < sg; ++s2) h = segP[s2 * 64 + c] * h + segH[s2 * 64 + c];
    }
#pragma unroll
    for (int tt = 0; tt < 8; ++tt) {
      const int t = sg * 8 + tt;
      h = a_s[t * 64 + c] * h + in_s[t * 64 + c];
      PJ[(size_t)(tok0 + t) * NPJ + C_RGG + cc] = f2bf(h * geluf(gt2[q][tt]));
    }
    if (isS) P.out[O_SRH + (size_t)(l * 128 + sseq) * 512 + cc] = h;
    else if ((chunk & 31) == 31 && sg == 7) P.out[O_PRH + (size_t)(l * 8 + (chunk >> 5)) * 512 + cc] = h;
  }
  if (isS) {
    for (int idx = tid; idx < 8 * 3 * 64; idx += 256) {
      const int c3 = idx & 63, i = (idx >> 6) % 3, sg = idx / 192;
      const int sseq = (tok0 - TP) / 8 + sg;
      P.out[O_SRC + ((size_t)(l * 128 + sseq) * 3 + i) * 512 + n * 64 + c3] = bf2f(PJ[(size_t)(tok0 + sg * 8 + 5 + i) * NPJ + C_RGX + n * 64 + c3]);
    }
  } else if ((chunk & 31) == 31) {
    if (tid < 192) {
      const int c3 = tid & 63, i = tid >> 6;
      P.out[O_PRC + ((size_t)(l * 8 + (chunk >> 5)) * 3 + i) * 512 + n * 64 + c3] = bf2f(PJ[(size_t)(tok0 + 61 + i) * NPJ + C_RGX + n * 64 + c3]);
    }
  }
}

DI void s5_task(const Params& P, int l, int chunk, int g, int mode, char* smem) {
  float* bu_s = (float*)smem;
  bfu* ss_b = (bfu*)(bu_s + 8192);
  float* segS = (float*)(ss_b + 64 * 136);
  float* car = segS + 1024;
  float* part = car + 128;
  const int tid = otid(), lane = tid & 63, wid = tid >> 6;
  bfu* PJ = (bfu*)(P.ws + WS_PROJ);
  const int tok0 = chunk * 64;
  const bool isS = chunk >= 256;
  const int p = tid & 63, tq = tid >> 6;
  const float* LAMT = (const float*)(P.ws + WS_S5LAM);
  const float lr = LAMT[(g * 64 + p) * 2], li = LAMT[(g * 64 + p) * 2 + 1];
  float* S5SUM = (float*)(P.ws + WS_S5SUM);
  bf16x8 cfr[4];
  float2 sprev[8];
  float uu[4], st0[4];
  const int hh = lane & 15;
  const float dco = P.in[27][l * 512 + g * 16 + hh];
  if (mode != 0) {
    const bfu* CC = (const bfu*)(P.ws + WS_S5CC) + (size_t)g * 2048;
#pragma unroll
    for (int ks = 0; ks < 4; ++ks) cfr[ks] = *(const bf16x8*)(CC + (lane & 15) * 128 + ks * 32 + (lane >> 4) * 8);
#pragma unroll
    for (int r = 0; r < 4; ++r) uu[r] = bf2f(PJ[(size_t)(tok0 + wid * 16 + (lane >> 4) * 4 + r) * NPJ + C_S5U + g * 16 + hh]);
    if (!isS) {
      const int ci = chunk & 31, cs = chunk & ~31;
#pragma unroll
      for (int i = 0; i < 8; ++i) {
        const int c2 = tq * 8 + i;
        sprev[i] = (c2 < ci) ? *(const float2*)(S5SUM + (((size_t)(cs + c2) * 32 + g) * 64 + p) * 2) : make_float2(0.f, 0.f);
      }
    } else {
#pragma unroll
      for (int q = 0; q < 2; ++q) {
        const size_t si0 = ((size_t)(l * 128 + (tok0 - TP) / 8 + tq + 4 * q) * 32 + g) * 64 + p;
        st0[2 * q] = P.in[4][si0]; st0[2 * q + 1] = P.in[5][si0];
      }
    }
  }
  {
    const bfu* BB = (const bfu*)(P.ws + WS_S5BB) + (size_t)g * 2048;
    const bf16x8 b = *(const bf16x8*)(BB + (wid * 32 + (lane & 31)) * 16 + (lane >> 5) * 8);
#pragma unroll
    for (int mt = 0; mt < 2; ++mt) {
      const bf16x8 a = *(const bf16x8*)(PJ + (size_t)(tok0 + mt * 32 + (lane & 31)) * NPJ + C_S5U + g * 16 + (lane >> 5) * 8);
      f32x16 d;
#pragma unroll
      for (int r = 0; r < 16; ++r) d[r] = 0.f;
      d = MFMA32(a, b, d);
#pragma unroll
      for (int r = 0; r < 16; ++r) bu_s[(mt * 32 + rowmap(r, lane)) * 128 + wid * 32 + (lane & 31)] = d[r];
    }
  }
  __syncthreads();
#pragma unroll
  for (int q = 0; q < 2; ++q) {
    const int sg = tq + 4 * q;
    float sr = 0.f, si = 0.f;
#pragma unroll
    for (int tt = 0; tt < 8; ++tt) {
      const int t = sg * 8 + tt;
      const float nr = lr * sr - li * si + bu_s[t * 128 + p];
      const float ni = lr * si + li * sr + bu_s[t * 128 + 64 + p];
      sr = nr; si = ni;
    }
    segS[(sg * 64 + p) * 2] = sr; segS[(sg * 64 + p) * 2 + 1] = si;
  }
  __syncthreads();
  float l8r = lr, l8i = li;
#pragma unroll
  for (int k = 0; k < 3; ++k) { const float nr = l8r * l8r - l8i * l8i, ni = 2.f * l8r * l8i; l8r = nr; l8i = ni; }
  if (mode == 0) {
    if (tid < 64) {
      float sr = 0.f, si = 0.f;
#pragma unroll
      for (int sg = 0; sg < 8; ++sg) {
        const float nr = l8r * sr - l8i * si + segS[(sg * 64 + p) * 2];
        const float ni = l8r * si + l8i * sr + segS[(sg * 64 + p) * 2 + 1];
        sr = nr; si = ni;
      }
      *(float2*)(S5SUM + (((size_t)chunk * 32 + g) * 64 + p) * 2) = make_float2(sr, si);
    }
    return;
  }
  if (!isS) {
    float l64r = l8r, l64i = l8i;
#pragma unroll
    for (int k = 0; k < 3; ++k) { const float nr = l64r * l64r - l64i * l64i, ni = 2.f * l64r * l64i; l64r = nr; l64i = ni; }
    const int ci = chunk & 31, cs = chunk & ~31;
    float ar = 0.f, ai = 0.f;
#pragma unroll
    for (int i = 0; i < 8; ++i) {
      const int c2 = tq * 8 + i;
      if (c2 < ci) {
        const float2 sv = sprev[i];
        const float nr = l64r * ar - l64i * ai + sv.x, ni = l64r * ai + l64i * ar + sv.y;
        ar = nr; ai = ni;
      }
    }
    part[(tq * 64 + p) * 2] = ar; part[(tq * 64 + p) * 2 + 1] = ai;
    __syncthreads();
    if (tid < 64) {
      float cr = 0.f, cim = 0.f;
      for (int q2 = 0; q2 < 4; ++q2) {
        const int cnt = min(max(ci - q2 * 8, 0), 8);
        for (int k = 0; k < cnt; ++k) { const float nr = l64r * cr - l64i * cim, ni = l64r * cim + l64i * cr; cr = nr; cim = ni; }
        cr += part[(q2 * 64 + p) * 2]; cim += part[(q2 * 64 + p) * 2 + 1];
      }
      car[p * 2] = cr; car[p * 2 + 1] = cim;
    }
    __syncthreads();
  }
#pragma unroll
  for (int q = 0; q < 2; ++q) {
    const int sg = tq + 4 * q;
    const int sseq = (tok0 - TP) / 8 + sg;
    float sr, si;
    if (isS) {
      sr = st0[2 * q]; si = st0[2 * q + 1];
    } else {
      sr = car[p * 2]; si = car[p * 2 + 1];
      for (int s2 = 0; s2 < sg; ++s2) {
        const float nr = l8r * sr - l8i * si + segS[(s2 * 64 + p) * 2];
        const float ni = l8r * si + l8i * sr + segS[(s2 * 64 + p) * 2 + 1];
        sr = nr; si = ni;
      }
    }
#pragma unroll
    for (int tt = 0; tt < 8; ++tt) {
      const int t = sg * 8 + tt;
      const float nr = lr * sr - li * si + bu_s[t * 128 + p];
      const float ni = lr * si + li * sr + bu_s[t * 128 + 64 + p];
      sr = nr; si = ni;
      ss_b[t * 136 + p] = f2bf(sr);
      ss_b[t * 136 + 64 + p] = f2bf(si);
    }
    if (isS) {
      const size_t so = ((size_t)(l * 128 + sseq) * 32 + g) * 64 + p;
      P.out[O_SSR + so] = sr; P.out[O_SSI + so] = si;
    } else if ((chunk & 31) == 31 && sg == 7) {
      const size_t so = ((size_t)(l * 8 + (chunk >> 5)) * 32 + g) * 64 + p;
      P.out[O_PSR + so] = sr; P.out[O_PSI + so] = si;
    }
  }
  __syncthreads();
  {
    f32x4 acc = {0.f, 0.f, 0.f, 0.f};
#pragma unroll
    for (int ks = 0; ks < 4; ++ks) {
      const bf16x8 a = *(const bf16x8*)(ss_b + (wid * 16 + (lane & 15)) * 136 + ks * 32 + (lane >> 4) * 8);
      acc = MFMA16(a, cfr[ks], acc);
    }
    const int h = hh;
#pragma unroll
    for (int r = 0; r < 4; ++r) {
      const int t = wid * 16 + (lane >> 4) * 4 + r;
      PJ[(size_t)(tok0 + t) * NPJ + C_S5U + g * 16 + h] = f2bf(geluf(acc[r] + dco * uu[r]));
    }
  }
}

DI void gdn_conv_col(const Params& P, int l, int chunk, int ch, float (&v)[64]) {
  const bfu* PJ = (const bfu*)(P.ws + WS_PROJ);
  const int tok0 = chunk * 64;
  const bool isS = chunk >= 256;
  const float* cw = P.in[32] + l * 4 * 1536;
  const float w0 = cw[ch], w1 = cw[1536 + ch], w2 = cw[2 * 1536 + ch], w3 = cw[3 * 1536 + ch];
  float x3 = 0.f, x2 = 0.f, x1 = 0.f;
  if (!isS && (chunk & 31) != 0) {
    x3 = bf2f(PJ[(size_t)(tok0 - 3) * NPJ + C_QKV + ch]);
    x2 = bf2f(PJ[(size_t)(tok0 - 2) * NPJ + C_QKV + ch]);
    x1 = bf2f(PJ[(size_t)(tok0 - 1) * NPJ + C_QKV + ch]);
  }
#pragma unroll
  for (int sg = 0; sg < 8; ++sg) {
    if (isS) {
      const float* st = P.in[6] + ((size_t)(l * 128 + (chunk - 256) * 8 + sg) * 3) * 1536 + ch;
      x3 = st[0]; x2 = st[1536]; x1 = st[2 * 1536];
    }
#pragma unroll
    for (int tt = 0; tt < 8; ++tt) {
      const int t = sg * 8 + tt;
      const float x = bf2f(PJ[(size_t)(tok0 + t) * NPJ + C_QKV + ch]);
      v[t] = siluf(w0 * x3 + w1 * x2 + w2 * x1 + w3 * x);
      x3 = x2; x2 = x1; x1 = x;
    }
  }
}

DI void gdn1_task(const Params& P, int l, int chunk, int head, char* smem) {
  bfu* qn_b = (bfu*)smem;
  bfu* kn_b = qn_b + 64 * 136;
  float* L_s = (float*)(kn_b + 64 * 136);
  float* rq = L_s + 4096;
  float* rk = rq + 64;
  float* sbeta = rk + 64;
  float* sg_ = sbeta + 64;
  float* gcs = sg_ + 64;
  float* eg = gcs + 64;
  float* gl = eg + 64;
  const int tid = otid(), lane = tid & 63, wid = tid >> 6;
  const bfu* PJ = (const bfu*)(P.ws + WS_PROJ);
  const int tok0 = chunk * 64;
  const bool isS = chunk >= 256;
  float v[64];
  gdn_conv_col(P, l, chunk, (tid < 128) ? (head * 128 + tid) : (512 + head * 128 + (tid - 128)), v);
  {
    bfu* dstb = (tid < 128) ? (qn_b + tid) : (kn_b + (tid - 128));
#pragma unroll
    for (int t = 0; t < 64; ++t) dstb[t * 136] = f2bf(v[t]);
  }
  if (tid < 64) {
    const float* AB = (const float*)(P.ws + WS_AB) + (size_t)(tok0 + tid) * 8;
    sbeta[tid] = sigm(AB[4 + head]);
    sg_[tid] = -__expf(P.in[33][l * 4 + head]) * softplusf(AB[head] + P.in[34][l * 4 + head]);
  }
  __syncthreads();
  if (tid < 128) {
    const bfu* rowp = (tid < 64 ? qn_b : kn_b) + (tid & 63) * 136;
    float s = 0.f;
    for (int d = 0; d < 128; ++d) { const float x = bf2f(rowp[d]); s += x * x; }
    if (tid < 64) rq[tid] = rsqrtf(s + 1e-6f) * 0.08838834764831845f;
    else rk[tid - 64] = rsqrtf(s + 1e-6f);
  } else if (tid < 136) {
    const int sg = tid - 128;
    if (isS) {
      float a = 0.f;
      for (int tt = 0; tt < 8; ++tt) { a += sg_[sg * 8 + tt]; gcs[sg * 8 + tt] = a; eg[sg * 8 + tt] = __expf(a); }
      gl[sg] = a;
    } else if (sg == 0) {
      float a = 0.f;
      for (int t = 0; t < 64; ++t) { a += sg_[t]; gcs[t] = a; eg[t] = __expf(a); }
      for (int s2 = 0; s2 < 8; ++s2) gl[s2] = a;
    }
  }
  __syncthreads();
  if (tid < 128) {
    bfu* QG = (bfu*)(P.ws + WS_GQG) + (size_t)tok0 * 512 + head * 128 + tid;
#pragma unroll
    for (int t = 0; t < 64; ++t) QG[(size_t)t * 512] = f2bf(v[t] * rq[t] * eg[t]);
    gdn_conv_col(P, l, chunk, 1024 + head * 128 + tid, v);
  } else {
    bfu* KD = (bfu*)(P.ws + WS_GKD) + (size_t)(chunk * 4 + head) * 8192 + (size_t)(tid - 128) * 64;
#pragma unroll
    for (int t8 = 0; t8 < 8; ++t8) {
      float kd[8];
#pragma unroll
      for (int e = 0; e < 8; ++e) {
        const int t = t8 * 8 + e;
        kd[e] = v[t] * rk[t] * __expf(gl[isS ? t8 : 0] - gcs[t]);
      }
      uint4 pk;
      pk.x = pk2(kd[0], kd[1]); pk.y = pk2(kd[2], kd[3]); pk.z = pk2(kd[4], kd[5]); pk.w = pk2(kd[6], kd[7]);
      *(uint4*)(KD + t8 * 8) = pk;
    }
  }
  {
    bfu* QK = (bfu*)(P.ws + WS_GQK) + (size_t)(chunk * 4 + head) * 4096;
    const int mt = wid >> 1, nt = wid & 1;
    f32x16 KK, QQ;
#pragma unroll
    for (int r = 0; r < 16; ++r) { KK[r] = 0.f; QQ[r] = 0.f; }
#pragma unroll
    for (int ks = 0; ks < 8; ++ks) {
      const bf16x8 ak = *(const bf16x8*)(kn_b + (mt * 32 + (lane & 31)) * 136 + ks * 16 + (lane >> 5) * 8);
      const bf16x8 aq = *(const bf16x8*)(qn_b + (mt * 32 + (lane & 31)) * 136 + ks * 16 + (lane >> 5) * 8);
      const bf16x8 bk = *(const bf16x8*)(kn_b + (nt * 32 + (lane & 31)) * 136 + ks * 16 + (lane >> 5) * 8);
      KK = MFMA32(ak, bk, KK);
      QQ = MFMA32(aq, bk, QQ);
    }
    const int j = nt * 32 + (lane & 31);
    const float gcj = gcs[j], rkj = rk[j];
#pragma unroll
    for (int r = 0; r < 16; ++r) {
      const int i = mt * 32 + rowmap(r, lane);
      const bool ok = (i >= j) && (!isS || ((i >> 3) == (j >> 3)));
      const float dec = ok ? __expf(gcs[i] - gcj) : 0.f;
      L_s[i * 64 + j] = (i > j) ? sbeta[i] * (rk[i] * rkj * KK[r]) * dec : 0.f;
      QK[i * 64 + j] = f2bf(rq[i] * rkj * QQ[r] * dec);
    }
  }
  __syncthreads();
  {
    if (tid < 128) {
#pragma unroll
      for (int t = 0; t < 64; ++t) v[t] *= sbeta[t];
    } else {
#pragma unroll
      for (int t = 0; t < 64; ++t) v[t] *= rk[t] * sbeta[t] * eg[t];
    }
#pragma unroll
    for (int i = 1; i < 64; ++i) {
      float s = v[i];
#pragma unroll
      for (int j4 = 0; j4 <= (i - 1) / 4; ++j4) {
        const float4 lv = *(const float4*)(L_s + i * 64 + j4 * 4);
        s -= lv.x * v[j4 * 4];
        if (j4 * 4 + 1 < i) s -= lv.y * v[j4 * 4 + 1];
        if (j4 * 4 + 2 < i) s -= lv.z * v[j4 * 4 + 2];
        if (j4 * 4 + 3 < i) s -= lv.w * v[j4 * 4 + 3];
      }
      v[i] = s;
    }
    bfu* dst = (bfu*)(P.ws + (tid < 128 ? WS_GU : WS_GW)) + (size_t)tok0 * 512 + head * 128 + (tid & 127);
#pragma unroll
    for (int t = 0; t < 64; ++t) dst[(size_t)t * 512] = f2bf(v[t]);
  }
  if (tid < 8) ((float*)(P.ws + WS_GDEC))[(chunk * 4 + head) * 32 + tid] = __expf(gl[tid]);
  if (isS) {
    for (int idx = tid; idx < 8 * 3 * 384; idx += 256) {
      const int cq = idx % 384, i = (idx / 384) % 3, sg = idx / 1152;
      const int ch = (cq >> 7) * 512 + head * 128 + (cq & 127);
      const int sseq = (chunk - 256) * 8 + sg;
      P.out[O_SGC + ((size_t)(l * 128 + sseq) * 3 + i) * 1536 + ch] = bf2f(PJ[(size_t)(tok0 + sg * 8 + 5 + i) * NPJ + C_QKV + ch]);
    }
  } else if ((chunk & 31) == 31) {
    for (int idx = tid; idx < 3 * 384; idx += 256) {
      const int cq = idx % 384, i = idx / 384;
      const int ch = (cq >> 7) * 512 + head * 128 + (cq & 127);
      P.out[O_PGC + ((size_t)(l * 8 + (chunk >> 5)) * 3 + i) * 1536 + ch] = bf2f(PJ[(size_t)(tok0 + 61 + i) * NPJ + C_QKV + ch]);
    }
  }
}

DI void gdn2_task(const Params& P, int l, int useq, int head, int dvs, char* smem) {
  bfu* Sb = (bfu*)smem;
  bfu* Vn = Sb + 32 * 136;
  const int tid = otid(), lane = tid & 63, w = tid >> 6;
  const bool isS = useq >= 8;
  const int sseq = useq - 8;
  const int nch = isS ? 1 : 32;
  const int chunk0 = isS ? (256 + (sseq >> 3)) : useq * 32;
  const int vseg = isS ? (sseq & 7) : -1;
  const bfu* GW = (const bfu*)(P.ws + WS_GW);
  const bfu* GQ = (const bfu*)(P.ws + WS_GQG);
  const bfu* GU = (const bfu*)(P.ws + WS_GU);
  bfu* PJO = (bfu*)(P.ws + WS_PROJ);
  const bfu* GKD = (const bfu*)(P.ws + WS_GKD);
  const bfu* GQK = (const bfu*)(P.ws + WS_GQK);
  const float* GDEC = (const float*)(P.ws + WS_GDEC);
  const int dv = dvs * 32 + (lane & 31);
  f32x16 S;
  if (isS) {
    const float* s0 = P.in[7] + ((size_t)((l * 128 + sseq) * 4 + head) * 128) * 128 + dv;
#pragma unroll
    for (int r = 0; r < 16; ++r) S[r] = s0[(size_t)(32 * w + rowmap(r, lane)) * 128];
  } else {
#pragma unroll
    for (int r = 0; r < 16; ++r) S[r] = 0.f;
  }
  const bf16x8 zero8 = {0, 0, 0, 0, 0, 0, 0, 0};
  for (int ci = 0; ci < nch; ++ci) {
    const int chunk = chunk0 + ci, tok0 = chunk * 64;
    const int mt = w & 1;
    const int row = mt * 32 + (lane & 31);
    const bool rvalid = !isS || ((row >> 3) == vseg);
    bf16x8 aA[8], aQ[4], aK[4];
    float uu[16];
    {
      const bfu* Ab = (w < 2 ? GW : GQ) + (size_t)(tok0 + row) * 512 + head * 128 + (lane >> 5) * 8;
#pragma unroll
      for (int ks = 0; ks < 8; ++ks) aA[ks] = rvalid ? *(const bf16x8*)(Ab + ks * 16) : zero8;
      const bfu* Kb = GKD + ((size_t)(chunk * 4 + head) * 128 + 32 * w + (lane & 31)) * 64 + (lane >> 5) * 8;
#pragma unroll
      for (int ks = 0; ks < 4; ++ks) {
        const bool gv = !isS || ((ks * 2 + (lane >> 5)) == vseg);
        aK[ks] = gv ? *(const bf16x8*)(Kb + ks * 16) : zero8;
      }
      if (w >= 2) {
        const bfu* Qb = GQK + ((size_t)(chunk * 4 + head) * 64 + row) * 64 + (lane >> 5) * 8;
#pragma unroll
        for (int ks = 0; ks < 4; ++ks) aQ[ks] = rvalid ? *(const bf16x8*)(Qb + ks * 16) : zero8;
#pragma unroll
        for (int r = 0; r < 16; ++r) uu[r] = 0.f;
      } else {
#pragma unroll
        for (int ks = 0; ks < 4; ++ks) aQ[ks] = zero8;
#pragma unroll
        for (int r = 0; r < 16; ++r) {
          const int t = mt * 32 + rowmap(r, lane);
          const bool tv = !isS || ((t >> 3) == vseg);
          uu[r] = tv ? bf2f(GU[(size_t)(tok0 + t) * 512 + head * 128 + dv]) : 0.f;
        }
      }
    }
    const float gdec = GDEC[(chunk * 4 + head) * 32 + (isS ? vseg : 0)];
    __syncthreads();
#pragma unroll
    for (int g4 = 0; g4 < 4; ++g4) {
      uint2 pk;
      pk.x = pk2(S[4 * g4], S[4 * g4 + 1]); pk.y = pk2(S[4 * g4 + 2], S[4 * g4 + 3]);
      *(uint2*)(Sb + (lane & 31) * 136 + 32 * w + 8 * g4 + 4 * (lane >> 5)) = pk;
    }
    __syncthreads();
    f32x16 acc;
#pragma unroll
    for (int r = 0; r < 16; ++r) acc[r] = 0.f;
#pragma unroll
    for (int ks = 0; ks < 8; ++ks) {
      const bf16x8 b8 = *(const bf16x8*)(Sb + (lane & 31) * 136 + ks * 16 + (lane >> 5) * 8);
      acc = MFMA32(aA[ks], b8, acc);
    }
    if (w < 2) {
#pragma unroll
      for (int g4 = 0; g4 < 4; ++g4) {
        uint2 pk;
        pk.x = pk2(uu[4 * g4] - acc[4 * g4], uu[4 * g4 + 1] - acc[4 * g4 + 1]);
        pk.y = pk2(uu[4 * g4 + 2] - acc[4 * g4 + 2], uu[4 * g4 + 3] - acc[4 * g4 + 3]);
        *(uint2*)(Vn + (lane & 31) * 72 + mt * 32 + 8 * g4 + 4 * (lane >> 5)) = pk;
      }
    }
    __syncthreads();
    if (w >= 2) {
#pragma unroll
      for (int ks = 0; ks < 4; ++ks) {
        const bf16x8 b8 = *(const bf16x8*)(Vn + (lane & 31) * 72 + ks * 16 + (lane >> 5) * 8);
        acc = MFMA32(aQ[ks], b8, acc);
      }
#pragma unroll
      for (int r = 0; r < 16; ++r) {
        const int t = mt * 32 + rowmap(r, lane);
        const bool tv = !isS || ((t >> 3) == vseg);
        if (tv) PJO[(size_t)(tok0 + t) * NPJ + C_QKV + (head * 4 + dvs) * 64 + (lane & 31)] = f2bf(acc[r]);
      }
    }
    {
#pragma unroll
      for (int r = 0; r < 16; ++r) S[r] *= gdec;
#pragma unroll
      for (int ks = 0; ks < 4; ++ks) {
        const bf16x8 b8 = *(const bf16x8*)(Vn + (lane & 31) * 72 + ks * 16 + (lane >> 5) * 8);
        S = MFMA32(aK[ks], b8, S);
      }
    }
  }
  float* so = P.out + (isS ? (O_SGS + ((size_t)((l * 128 + sseq) * 4 + head) * 128) * 128)
                           : (O_PGS + ((size_t)((l * 8 + useq) * 4 + head) * 128) * 128)) + dv;
#pragma unroll
  for (int r = 0; r < 16; ++r) so[(size_t)(32 * w + rowmap(r, lane)) * 128] = S[r];
}

DI void gdn3_pass(const Params& P, int l) {
  const int tid_ = otid(), lane = tid_ & 63, wid = tid_ >> 6;
  const bool bal = (gridDim.x == 512), freeb = bal && (blockIdx.x >= 272);
  const int nw = bal ? (freeb ? 960 : 1088) : (int)gridDim.x * 4;
  const int gw = (freeb ? ((int)blockIdx.x - 272) : (int)blockIdx.x) * 4 + wid;
  const int r0 = (bal && !freeb) ? 15232 : 0, r1 = freeb ? 15232 : T_ALL;
  const bfu* GU = (const bfu*)(P.ws + WS_GU);
  bfu* PJ = (bfu*)(P.ws + WS_PROJ);
  const float* nwt = P.in[35] + l * 128 + (lane & 15) * 8;
  for (int r = r0 + gw; r < r1; r += nw) {
    const uint4 ov = *(const uint4*)(PJ + (size_t)r * NPJ + C_QKV + (lane >> 2) * 64 + (lane & 3) * 8);
    const uint4 zv = *(const uint4*)(PJ + (size_t)r * NPJ + C_Z + lane * 8);
    float o[8], z[8];
    const unsigned ow[4] = {ov.x, ov.y, ov.z, ov.w}, zw[4] = {zv.x, zv.y, zv.z, zv.w};
    float ss = 0.f;
#pragma unroll
    for (int e = 0; e < 4; ++e) {
      o[2 * e] = __uint_as_float(ow[e] << 16); o[2 * e + 1] = __uint_as_float(ow[e] & 0xffff0000u);
      z[2 * e] = __uint_as_float(zw[e] << 16); z[2 * e + 1] = __uint_as_float(zw[e] & 0xffff0000u);
      ss += o[2 * e] * o[2 * e] + o[2 * e + 1] * o[2 * e + 1];
    }
    ss += __shfl_xor(ss, 1, 64); ss += __shfl_xor(ss, 2, 64); ss += __shfl_xor(ss, 4, 64); ss += __shfl_xor(ss, 8, 64);
    const float rn = rsqrtf(ss * (1.f / 128.f) + 1e-6f);
    float res[8];
#pragma unroll
    for (int e = 0; e < 8; ++e) res[e] = o[e] * rn * nwt[e] * siluf(z[e]);
    uint4 pk;
    pk.x = pk2(res[0], res[1]); pk.y = pk2(res[2], res[3]); pk.z = pk2(res[4], res[5]); pk.w = pk2(res[6], res[7]);
    *(uint4*)(PJ + (size_t)r * NPJ + C_Z + lane * 8) = pk;
  }
}

DI void phase_mix1a(const Params& P, int l, char* smem) {
  for (int t = blockIdx.x; t < 1088; t += gridDim.x) {
    __syncthreads();
    gdn1_task(P, l, t >> 2, t & 3, smem);
  }
}
DI void phase_mix1b(const Params& P, int l, char* smem) {
  const int NT = 2048 + 8192;
  for (int t = blockIdx.x; t < NT; t += gridDim.x) {
    __syncthreads();
    if (t < 2048) rg_task(P, l, t >> 3, t & 7, 0, smem);
    else { const int r = t - 2048; s5_task(P, l, r >> 5, r & 31, 0, smem); }
  }
}

DI void phase_mix2(const Params& P, int l, char* smem) {
  const int G = gridDim.x;
  for (int t = blockIdx.x; t < 128; t += G) {
    __syncthreads();
    gdn2_task(P, l, t >> 4, (t >> 2) & 3, t & 3, smem);
  }
  unsigned* ctr = (unsigned*)(P.ws + WS_BAR) + XB_WORDS + 64 * (1 + l);
  volatile int* nxt = (volatile int*)(smem + LDS_BYTES - 16);
  const int NR = 2176 + 2176 + 2048;
  for (;;) {
    __syncthreads();
    if (threadIdx.x == 0) *nxt = (int)__hip_atomic_fetch_add(ctr, 1u, __ATOMIC_RELAXED, __HIP_MEMORY_SCOPE_AGENT);
    __syncthreads();
    const int r = *nxt;
    if (r >= NR) break;
    __syncthreads();
    if (r < 2176) {
#pragma unroll 1
      for (int gg = 0; gg < 4; ++gg) { if (gg) __syncthreads(); s5_task(P, l, r >> 3, (r & 7) * 4 + gg, 1, smem); }
    } else if (r < 4352) { const int q = r - 2176; rg_task(P, l, q >> 3, q & 7, 1, smem); }
    else { const int q = r - 4352; gdn2_task(P, l, 8 + (q >> 4), (q >> 2) & 3, q & 3, smem); }
  }
}

__global__ void __launch_bounds__(256, 2) mega_kernel(Params P) {
  extern __shared__ __attribute__((aligned(16))) char smem[];
  cg::grid_group grid = cg::this_grid();
  char* ws = P.ws;
  if (P.out == nullptr) grid.sync();
  GBar gb;
  gbar_init(gb, (unsigned*)(ws + WS_BAR));
  prep_layer(P, 0, smem);
  norm_pass(P, 0, 0, smem);
  gsync(gb);
#pragma unroll 1
  for (int l = 0; l < 2; ++l) {
    gemm_plain((const bfu*)(ws + WS_H), 1024, (const bfu*)(ws + WS_WIN), 1024, 1024, 3584, (bfu*)(ws + WS_PROJ), NPJ, smem);
    gsync(gb);
    phase_mix1b(P, l, smem);
    gsync(gb);
    phase_mix1a(P, l, smem);
    gsync(gb);
    phase_mix2(P, l, smem);
    gsync(gb);
    gemm_glu(P, l, smem);
    gdn3_pass(P, l);
    gsync(gb);
    gemm_merge(P, smem);
    gsync(gb);
    gemm_plain((const bfu*)(ws + WS_MIXED), 1024, (const bfu*)(ws + WS_WOUT), 1024, 1024, 1024, (bfu*)(ws + WS_MO), 1024, smem);
    gsync(gb);
    norm_pass(P, l, 1, smem);
    gsync(gb);
    gemm_ffn1(P, smem);
    gsync(gb);
    gemm_plain((const bfu*)(ws + WS_ACT), 2816, (const bfu*)(ws + WS_WDN), 2816, 2816, 1024, (bfu*)(ws + WS_FO), 1024, smem);
    gsync(gb);
    norm_pass(P, l, 2, smem);
    if (l == 0) prep_layer(P, 1, smem);
    gsync(gb);
  }
}

extern "C" void kernel_launch(void* const* d_in, const int* in_sizes, int n_in, void* d_out, int out_size, void* d_ws, size_t ws_size,
                              hipStream_t stream) {
  static int grid_blocks = 0;
  if (!grid_blocks) {
    int dev = 0, cus = 0, per_cu = 0;
    hipGetDevice(&dev);
    hipDeviceGetAttribute(&cus, hipDeviceAttributeMultiprocessorCount, dev);
    hipFuncSetAttribute((const void*)mega_kernel, hipFuncAttributeMaxDynamicSharedMemorySize, LDS_BYTES);
    hipOccupancyMaxActiveBlocksPerMultiprocessor(&per_cu, mega_kernel, 256, LDS_BYTES);
    if (per_cu > 2) per_cu = 2;
    if (per_cu < 1) per_cu = 1;
    grid_blocks = cus * per_cu;
    grid_blocks &= ~7;
  }
  if (ws_size < WS_END) { fprintf(stderr, "workspace too small: %zu < %zu\n", ws_size, (size_t)WS_END); return; }
  Params p{};
  for (int i = 0; i < 41; ++i) p.in[i] = (const float*)d_in[i];
  p.out = (float*)d_out;
  p.ws = (char*)d_ws;
  hipMemsetAsync((char*)d_ws + WS_BAR, 0, 16384, stream);
  void* args[] = {&p};
  hipError_t e = hipLaunchCooperativeKernel((const void*)mega_kernel, dim3(grid_blocks), dim3(256), args, LDS_BYTES, stream);
  if (e != hipSuccess) fprintf(stderr, "cooperative launch failed: %s (grid %d)\n", hipGetErrorString(e), grid_blocks);
}
```
